# Optimizing an MI355X kernel written in HIP

```python
import math
import jax, jax.numpy as jnp
from jax import lax
import numpy as np

D_MODEL = 2048
BATCH = 2
SEQ = 4096
DEPTH = 1

CHUNK = 64
Q_BLOCK = 128
N_ATTN_HEADS = 8
ATTN_HEAD_DIM = 64
ATTN_V_DIM = 2 * ATTN_HEAD_DIM
ATTN_WIDTH = N_ATTN_HEADS * ATTN_V_DIM
CONV_WIDTH = D_MODEL - ATTN_WIDTH
CONV_GROUPS = 8
CONV_K = 3
D_FF = (8 * D_MODEL + 3 * 256 - 1) // (3 * 256) * 256
ROPE_THETA = 10000.0
EPS = 1e-6
SUBLN_EPS = 1e-5
QK_COLS = N_ATTN_HEADS * 2 * ATTN_HEAD_DIM
IN_COLS = 2 * QK_COLS + ATTN_WIDTH + 3 * CONV_WIDTH

kernel_name = "hybrid_diffattn_shortconv_block"


def lambda_init(layer_idx):
    return 0.8 - 0.6 * math.exp(-0.3 * layer_idx)


def rms_norm(x, w, eps=EPS):
    xf = x.astype(jnp.float32)
    y = xf * lax.rsqrt(jnp.mean(xf * xf, axis=-1, keepdims=True) + eps)
    return (y * w.astype(jnp.float32)).astype(x.dtype)


def rope(t, cos, sin):
    tf = t.astype(jnp.float32)
    half = tf.shape[-1] // 2
    t1, t2 = tf[..., :half], tf[..., half:]
    c = cos[None, :, None, None, :]
    s = sin[None, :, None, None, :]
    out = jnp.concatenate([t1 * c - t2 * s, t2 * c + t1 * s], axis=-1)
    return out.astype(t.dtype)


def diff_attention(q, k, v, lam):
    b, s, h, _, dk = q.shape
    nb = s // Q_BLOCK
    scale = 1.0 / math.sqrt(dk)
    qb = q.reshape(b, nb, Q_BLOCK, h, 2, dk).transpose(1, 0, 2, 3, 4, 5)
    key_chunk = jnp.arange(s) // CHUNK

    def block(args):
        qi, i = args
        q_chunk = (i * Q_BLOCK + jnp.arange(Q_BLOCK)) // CHUNK
        mask = key_chunk[None, :] <= q_chunk[:, None]
        sc = jnp.einsum('bqhcd,bkhcd->bhcqk', qi, k).astype(jnp.float32) * scale
        sc = jnp.where(mask[None, None, None], sc, -1e30)
        p = jax.nn.softmax(sc, axis=-1)
        a = p[:, :, 0] - lam * p[:, :, 1]
        return jnp.einsum('bhqk,bkhd->bqhd', a.astype(v.dtype), v)

    out = lax.map(block, (qb, jnp.arange(nb)))
    return out.transpose(1, 0, 2, 3, 4).reshape(b, s, h, v.shape[-1])


def causal_depthwise_conv(u, w):
    c = u.shape[-1]
    return lax.conv_general_dilated(
        u, w[:, None, :].astype(u.dtype), window_strides=(1,),
        padding=[(CONV_K - 1, 0)], dimension_numbers=('NWC', 'WIO', 'NWC'),
        feature_group_count=c)


def setup_inputs(seed: int = 0) -> dict:
    key = jax.random.key(seed)
    ks = jax.random.split(key, 16)
    f32 = jnp.float32
    nrm = lambda k, shape, s: jax.random.normal(k, shape, f32) * s
    return {
        "x": jax.random.normal(ks[0], (BATCH, SEQ, D_MODEL), f32),
        "attn_norm_w": 1.0 + nrm(ks[1], (DEPTH, D_MODEL), 0.02),
        "w_in": nrm(ks[2], (DEPTH, D_MODEL, IN_COLS), D_MODEL ** -0.5),
        "q_norm_w": 1.0 + nrm(ks[3], (DEPTH, ATTN_HEAD_DIM), 0.02),
        "k_norm_w": 1.0 + nrm(ks[4], (DEPTH, ATTN_HEAD_DIM), 0.02),
        "lambda_q1": nrm(ks[5], (DEPTH, ATTN_HEAD_DIM), 0.1),
        "lambda_k1": nrm(ks[6], (DEPTH, ATTN_HEAD_DIM), 0.1),
        "lambda_q2": nrm(ks[7], (DEPTH, ATTN_HEAD_DIM), 0.1),
        "lambda_k2": nrm(ks[8], (DEPTH, ATTN_HEAD_DIM), 0.1),
        "subln_w": 1.0 + nrm(ks[9], (DEPTH, ATTN_V_DIM), 0.02),
        "conv_w": nrm(ks[10], (DEPTH, CONV_K, CONV_WIDTH), CONV_K ** -0.5),
        "w_out": nrm(ks[11], (DEPTH, D_MODEL, D_MODEL), D_MODEL ** -0.5),
        "ffn_norm_w": 1.0 + nrm(ks[12], (DEPTH, D_MODEL), 0.02),
        "w_gate": nrm(ks[13], (DEPTH, D_MODEL, D_FF), D_MODEL ** -0.5),
        "w_up": nrm(ks[14], (DEPTH, D_MODEL, D_FF), D_MODEL ** -0.5),
        "w_down": nrm(ks[15], (DEPTH, D_FF, D_MODEL), D_FF ** -0.5),
    }


def reference(x, attn_norm_w, w_in, q_norm_w, k_norm_w, lambda_q1, lambda_k1,
              lambda_q2, lambda_k2, subln_w, conv_w, w_out, ffn_norm_w,
              w_gate, w_up, w_down):
    b, s, _ = x.shape
    pos = jnp.arange(s, dtype=jnp.float32)
    inv_freq = ROPE_THETA ** (-jnp.arange(0, ATTN_HEAD_DIM, 2, dtype=jnp.float32) / ATTN_HEAD_DIM)
    ang = pos[:, None] * inv_freq[None, :]
    cos, sin = jnp.cos(ang), jnp.sin(ang)

    h_res = x
    for l in range(DEPTH):
        lam_init = lambda_init(l)
        xn = rms_norm(h_res, attn_norm_w[l])
        proj = jnp.einsum('bsd,de->bse', xn, w_in[l])
        o1 = QK_COLS
        o2 = o1 + QK_COLS
        o3 = o2 + ATTN_WIDTH
        o4 = o3 + CONV_WIDTH
        o5 = o4 + CONV_WIDTH
        q = proj[..., :o1].reshape(b, s, N_ATTN_HEADS, 2, ATTN_HEAD_DIM)
        k = proj[..., o1:o2].reshape(b, s, N_ATTN_HEADS, 2, ATTN_HEAD_DIM)
        v = proj[..., o2:o3].reshape(b, s, N_ATTN_HEADS, ATTN_V_DIM)
        gate_b = proj[..., o3:o4]
        gate_c = proj[..., o4:o5]
        hc = proj[..., o5:]

        q = rope(rms_norm(q, q_norm_w[l]), cos, sin)
        k = rope(rms_norm(k, k_norm_w[l]), cos, sin)
        lam = (jnp.exp(jnp.sum(lambda_q1[l].astype(jnp.float32) * lambda_k1[l].astype(jnp.float32)))
               - jnp.exp(jnp.sum(lambda_q2[l].astype(jnp.float32) * lambda_k2[l].astype(jnp.float32)))
               + lam_init)
        attn = diff_attention(q, k, v, lam)
        attn = rms_norm(attn, subln_w[l], SUBLN_EPS) * (1.0 - lam_init)
        attn = attn.reshape(b, s, ATTN_WIDTH)

        conv = gate_b * causal_depthwise_conv(gate_c * hc, conv_w[l])

        mixed = jnp.concatenate([attn.astype(conv.dtype), conv], axis=-1)
        h_res = h_res + jnp.einsum('bse,ed->bsd', mixed, w_out[l])

        fn = rms_norm(h_res, ffn_norm_w[l])
        g = jnp.einsum('bsd,df->bsf', fn, w_gate[l])
        u = jnp.einsum('bsd,df->bsf', fn, w_up[l])
        h_res = h_res + jnp.einsum('bsf,fd->bsd', jax.nn.silu(g) * u, w_down[l])
    return h_res
```

```cpp
#include <hip/hip_runtime.h>
#include <cstdio>
#include <cstdint>
namespace pg8 {
#define PG8_LAS __attribute__((address_space(3)))
typedef unsigned short bf16_t;
typedef short bf16x8 __attribute__((ext_vector_type(8)));
typedef float f32x4 __attribute__((ext_vector_type(4)));
typedef unsigned u32x4 __attribute__((ext_vector_type(4)));
constexpr int BM = 256, BK = 64, HALF = 128, HTB = HALF * BK * 2  , STAGE_BYTES = 8 * HTB, NXCD = 8, WGM = 8;

__host__ __device__ __forceinline__ int lds_byte(int r, int c) { const int st = (r >> 4) * 2 + (c >> 5), rr = r & 15, cc = c & 31, ob = rr * 64 + cc * 2; return st * 1024 + (ob ^ (((ob >> 9) & 1) << 5)); }
__host__ __device__ __forceinline__ void stage_rc(int b, int& R, int& C) { const int st = b / 1024, sb = b % 1024, swz = sb ^ (((sb >> 9) & 1) << 5); R = (st >> 1) * 16 + swz / 64; C = (st & 1) * 32 + (swz % 64) / 2; }
__host__ __device__ __forceinline__ int perm32(int rho) { const int n = rho >> 4, i = rho & 15; return 8 * (i >> 2) + 4 * n + (i & 3); }

struct Unit { int pm, pn, idx; };
struct Gemm { const bf16_t* A; const bf16_t* Bt; int M, N, K; };

struct StaticOrder {
    int nM, nN, nwg, G, c;
    __host__ __device__ void init(int M, int N, int G_, int c_) { nM = M / BM; nN = N / BM; nwg = nM * nN; G = G_; c = c_; }
    __host__ __device__ bool next(int i, Unit& u) const {
        const long L = (long)i * G + c; if (L >= nwg) return false;
        int wgid = (int)L; { const int q = nwg / NXCD, r = nwg % NXCD, xcd = wgid % NXCD, off = wgid / NXCD; wgid = (xcd < r ? xcd * (q + 1) : r * (q + 1) + (xcd - r) * q) + off; }
        const int nig = WGM * nN, gid = wgid / nig, fm = gid * WGM, gsz = (nM - fm) < WGM ? (nM - fm) : WGM;
        u.pm = fm + ((wgid % nig) % gsz); u.pn = (wgid % nig) / gsz; u.idx = i; return true;
    }
    __device__ __forceinline__ void a_ready(const Unit&) const {}
    __device__ __forceinline__ void done(const Unit&) const {}
};

__device__ __forceinline__ unsigned cvt_pk_bf16(float lo, float hi) { unsigned r; asm volatile("v_cvt_pk_bf16_f32 %0, %1, %2" : "=v"(r) : "v"(lo), "v"(hi)); return r; }
typedef float f32x2 __attribute__((ext_vector_type(2)));
__device__ __forceinline__ f32x2 gelu_pk(f32x2 v) {
    const f32x2 av = __builtin_elementwise_abs(v), d = av * 0.2316418882f + 1.0f;
    f32x2 t; t.x = __builtin_amdgcn_rcpf(d.x); t.y = __builtin_amdgcn_rcpf(d.y);
    f32x2 q = t * 0.5307027145f + (-0.7265760135f); q = q * t + 0.7107068705f; q = q * t + (-0.142248368f); q = q * t + 0.127414796f; q = q * t;
    const f32x2 s = (v * v) * (-0.72134752044f);
    f32x2 e; e.x = __builtin_amdgcn_exp2f(s.x); e.y = __builtin_amdgcn_exp2f(s.y);
    const f32x2 m = v * (q * e), r = v - m;
    f32x2 o; o.x = v.x < 0.f ? m.x : r.x; o.y = v.y < 0.f ? m.y : r.y; return o;
}

template <int ACT  > struct EpiBf16 {
    static constexpr bool PERM = true, AFTER_DRAIN = false; static_assert(ACT == 0 || ACT == 1, "EpiBf16: ACT is 0 (none) or 1 (gelu_pk)");
    bf16_t* O; int ldc; const float* bias; int split_cols; size_t split_stride; float scale0;
    __device__ __forceinline__ void operator()(const f32x4 (&acc)[2][2][4][2], const Unit& u, int wr, int wc, int fr, int fq) const {
        const int row0 = u.pm * BM + wr * 64 + fr; int colt = u.pn * BM; bf16_t* base = O;
        float sc = 1.f; if (split_cols) { const int t = colt / split_cols; base += (size_t)t * split_stride; colt -= t * split_cols; if (t == 0) sc = scale0; }
        const int col0 = colt + wc * 32 + 8 * fq, bcol0 = u.pn * BM + wc * 32 + 8 * fq;
        f32x4 bv[2][2];
#pragma unroll
        for (int bj = 0; bj < 2; ++bj)
#pragma unroll
            for (int n = 0; n < 2; ++n) bv[bj][n] = bias ? *(const f32x4*)(bias + bcol0 + bj * HALF + 4 * n) : (f32x4){0.f, 0.f, 0.f, 0.f};
#pragma unroll
        for (int ai = 0; ai < 2; ++ai)
#pragma unroll
            for (int m = 0; m < 4; ++m) { bf16_t* rowp = base + (size_t)(row0 + ai * HALF + m * 16) * ldc + col0;
#pragma unroll
                for (int bj = 0; bj < 2; ++bj) { f32x4 v0 = acc[ai][bj][m][0] + bv[bj][0], v1 = acc[ai][bj][m][1] + bv[bj][1];
                    if (ACT == 1) { f32x2 a = gelu_pk((f32x2){v0[0], v0[1]}), b = gelu_pk((f32x2){v0[2], v0[3]}), c = gelu_pk((f32x2){v1[0], v1[1]}), d = gelu_pk((f32x2){v1[2], v1[3]});
                        v0 = (f32x4){a.x, a.y, b.x, b.y}; v1 = (f32x4){c.x, c.y, d.x, d.y}; }
                    v0 = v0 * sc; v1 = v1 * sc; u32x4 w; w.x = cvt_pk_bf16(v0[0], v0[1]); w.y = cvt_pk_bf16(v0[2], v0[3]); w.z = cvt_pk_bf16(v1[0], v1[1]); w.w = cvt_pk_bf16(v1[2], v1[3]);
                    *(u32x4*)(rowp + bj * HALF) = w; } }
    }
};
struct EpiSwiGLU {
    static constexpr bool PERM = true, AFTER_DRAIN = false;
    bf16_t* H; int ldh; const PG8_LAS float* rtab  ;
    static __device__ __forceinline__ float silu_mul(float g, float u) { return g * __builtin_amdgcn_rcpf(1.0f + __builtin_amdgcn_exp2f(-1.4426950408889634f * g)) * u; }
    __device__ __forceinline__ void operator()(const f32x4 (&acc)[2][2][4][2], const Unit& u, int wr, int wc, int fr, int fq) const {
        const int row0 = u.pm * BM + wr * 64 + fr, col0 = u.pn * HALF + wc * 32 + 8 * fq;
#pragma unroll
        for (int ai = 0; ai < 2; ++ai)
#pragma unroll
            for (int m = 0; m < 4; ++m) { const int row = row0 + ai * HALF + m * 16; bf16_t* rowp = H + (size_t)row * ldh + col0;
                const float rstd = rtab[256 * u.idx + ai * HALF + wr * 64 + m * 16 + fr];
                const f32x4 g0 = acc[ai][0][m][0] * rstd, g1 = acc[ai][0][m][1] * rstd, u0 = acc[ai][1][m][0] * rstd, u1 = acc[ai][1][m][1] * rstd;
                u32x4 w; w.x = cvt_pk_bf16(silu_mul(g0[0], u0[0]), silu_mul(g0[1], u0[1])); w.y = cvt_pk_bf16(silu_mul(g0[2], u0[2]), silu_mul(g0[3], u0[3]));
                w.z = cvt_pk_bf16(silu_mul(g1[0], u1[0]), silu_mul(g1[1], u1[1])); w.w = cvt_pk_bf16(silu_mul(g1[2], u1[2]), silu_mul(g1[3], u1[3]));
                *(u32x4*)rowp = w; }
    }
};
struct EpiInProj {
    static constexpr bool PERM = true, AFTER_DRAIN = false;
    bf16_t* O; size_t stride; const float* qnw; const float* knw; const float* rope  ; float qscale; int seqmask;
    const PG8_LAS float* rxt  ;
    __device__ __forceinline__ void operator()(const f32x4 (&acc)[2][2][4][2], const Unit& u, int wr, int wc, int fr, int fq) const {
        const int row0 = u.pm * BM + wr * 64 + fr; const int g = u.pn >> 2, sub = u.pn & 3; const PG8_LAS float* rx0 = rxt + 256 * u.idx + wr * 64 + fr;
        if (g == 0 || g == 3) {
            const bool isq = (g == 0); bf16_t* base = O + (isq ? (size_t)0 : stride); const int colt = sub * BM;
            const float* nwp = (isq ? qnw : knw) + 8 * fq; const float sc = isq ? qscale : 1.0f;
            f32x4 w1[2], w2[2];
#pragma unroll
            for (int n = 0; n < 2; ++n) { w1[n] = *(const f32x4*)(nwp + 4 * n) * sc; w2[n] = *(const f32x4*)(nwp + 32 + 4 * n) * sc; }
#pragma unroll
            for (int am = 0; am < 4; ++am) { const int ai = am >> 1;
                f32x4 c01[4][4];
#pragma unroll
                for (int m = 2 * (am & 1); m < 2 * (am & 1) + 2; ++m) { const float* cs = rope + ((size_t)((row0 + ai * HALF + m * 16) & seqmask) * 32 + 8 * fq) * 2;
#pragma unroll
                    for (int q = 0; q < 4; ++q) c01[m][q] = *(const f32x4*)(cs + 4 * q); }
#pragma unroll
                for (int m = 2 * (am & 1); m < 2 * (am & 1) + 2; ++m) { const int row = row0 + ai * HALF + m * 16;
                    float ss = 0.f;
#pragma unroll
                    for (int n = 0; n < 2; ++n) { const f32x4 a = acc[ai][0][m][n], b = acc[ai][1][m][n]; ss += (a[0] * a[0] + a[1] * a[1]) + (a[2] * a[2] + a[3] * a[3]) + (b[0] * b[0] + b[1] * b[1]) + (b[2] * b[2] + b[3] * b[3]); }
                    ss += __shfl_xor(ss, 16); ss += __shfl_xor(ss, 32);
                    const float rx = rx0[ai * HALF + m * 16];
                    const float rstd = rx / sqrtf(ss * rx * rx * (1.0f / 64.0f) + 1e-6f);
                    float o1[8], o2[8];
#pragma unroll
                    for (int n = 0; n < 2; ++n)
#pragma unroll
                        for (int i = 0; i < 4; ++i) { const float y1 = acc[ai][0][m][n][i] * rstd * w1[n][i], y2 = acc[ai][1][m][n][i] * rstd * w2[n][i];
                            const f32x4 cc = c01[m][2 * n + (i >> 1)]; const float c = cc[2 * (i & 1)], s = cc[2 * (i & 1) + 1];
                            o1[4 * n + i] = y1 * c - y2 * s; o2[4 * n + i] = y2 * c + y1 * s; }
                    bf16_t* rowp = base + (size_t)row * 1024 + colt + 64 * wc + 8 * fq;
                    u32x4 wa, wb; wa.x = cvt_pk_bf16(o1[0], o1[1]); wa.y = cvt_pk_bf16(o1[2], o1[3]); wa.z = cvt_pk_bf16(o1[4], o1[5]); wa.w = cvt_pk_bf16(o1[6], o1[7]);
                    wb.x = cvt_pk_bf16(o2[0], o2[1]); wb.y = cvt_pk_bf16(o2[2], o2[3]); wb.z = cvt_pk_bf16(o2[4], o2[5]); wb.w = cvt_pk_bf16(o2[6], o2[7]);
                    *(u32x4*)rowp = wa; *(u32x4*)(rowp + 32) = wb; } }
        } else if (g == 2 || g == 5) {
            bf16_t* ub = O + 4 * stride; const int col0 = ((g == 5 ? 4 : 0) + sub) * HALF + wc * 32 + 8 * fq;
#pragma unroll
            for (int ai = 0; ai < 2; ++ai)
#pragma unroll
                for (int m = 0; m < 4; ++m) { const float rx = rx0[ai * HALF + m * 16], rx2 = rx * rx; const f32x4 v0 = acc[ai][0][m][0] * acc[ai][1][m][0] * rx2, v1 = acc[ai][0][m][1] * acc[ai][1][m][1] * rx2;
                    u32x4 w; w.x = cvt_pk_bf16(v0[0], v0[1]); w.y = cvt_pk_bf16(v0[2], v0[3]); w.z = cvt_pk_bf16(v1[0], v1[1]); w.w = cvt_pk_bf16(v1[2], v1[3]);
                    *(u32x4*)(ub + (size_t)(row0 + ai * HALF + m * 16) * 1024 + col0) = w; }
        } else {
            bf16_t* base = O + (g == 1 ? 2 : 3) * stride; const int col0 = sub * BM + wc * 32 + 8 * fq;
#pragma unroll
            for (int ai = 0; ai < 2; ++ai)
#pragma unroll
                for (int m = 0; m < 4; ++m) { bf16_t* rowp = base + (size_t)(row0 + ai * HALF + m * 16) * 1024 + col0; const float rx = rx0[ai * HALF + m * 16];
#pragma unroll
                    for (int bj = 0; bj < 2; ++bj) { const f32x4 v0 = acc[ai][bj][m][0] * rx, v1 = acc[ai][bj][m][1] * rx;
                        u32x4 w; w.x = cvt_pk_bf16(v0[0], v0[1]); w.y = cvt_pk_bf16(v0[2], v0[3]); w.z = cvt_pk_bf16(v1[0], v1[1]); w.w = cvt_pk_bf16(v1[2], v1[3]);
                        *(u32x4*)(rowp + bj * HALF) = w; } }
        }
    }
};
struct EpiResStats {
    static constexpr bool PERM = false, AFTER_DRAIN = false;
    const bf16_t* base  ; int ldc; bf16_t* ob; float* ss;
    __device__ __forceinline__ void operator()(const f32x4 (&acc)[2][2][4][2], const Unit& u, int wr, int wc, int fr, int fq) const {
        typedef unsigned u32x2v __attribute__((ext_vector_type(2)));
        const int col0 = u.pn * BM + wc * 32 + 4 * fq;
#pragma unroll
        for (int ai = 0; ai < 2; ++ai)
#pragma unroll
            for (int m = 0; m < 4; ++m) { const size_t off = (size_t)(u.pm * BM + ai * HALF + wr * 64 + m * 16 + fr) * ldc + col0;
                u32x2v bs[2][2];
#pragma unroll
                for (int bj = 0; bj < 2; ++bj)
#pragma unroll
                    for (int n = 0; n < 2; ++n) bs[bj][n] = *(const u32x2v*)(base + off + bj * HALF + n * 16);
                float s = 0.f;
#pragma unroll
                for (int bj = 0; bj < 2; ++bj)
#pragma unroll
                    for (int n = 0; n < 2; ++n) { const u32x2v b = bs[bj][n]; const f32x4 o = (f32x4){__builtin_bit_cast(float, b.x << 16), __builtin_bit_cast(float, b.x & 0xffff0000u), __builtin_bit_cast(float, b.y << 16), __builtin_bit_cast(float, b.y & 0xffff0000u)} + acc[ai][bj][m][n]; s += (o[0] * o[0] + o[1] * o[1]) + (o[2] * o[2] + o[3] * o[3]);
                        u32x2v w; w.x = cvt_pk_bf16(o[0], o[1]); w.y = cvt_pk_bf16(o[2], o[3]); *(u32x2v*)(ob + off + bj * HALF + n * 16) = w; }
                s += __shfl_xor(s, 16); s += __shfl_xor(s, 32);
                if (fq == 0) ss[(size_t)(u.pm * BM + ai * HALF + wr * 64 + m * 16 + fr) * 32 + 4 * u.pn + wc] = s; }
    }
};
struct EpiResOut {
    static constexpr bool PERM = false, AFTER_DRAIN = false;
    const bf16_t* hb; float* out; int ldc;
    __device__ __forceinline__ void operator()(const f32x4 (&acc)[2][2][4][2], const Unit& u, int wr, int wc, int fr, int fq) const {
        typedef unsigned u32x2v __attribute__((ext_vector_type(2)));
        const int col0 = u.pn * BM + wc * 32 + 4 * fq;
#pragma unroll
        for (int ai = 0; ai < 2; ++ai)
#pragma unroll
            for (int m = 0; m < 4; ++m) { const size_t off = (size_t)(u.pm * BM + ai * HALF + wr * 64 + m * 16 + fr) * ldc + col0;
                u32x2v bs[2][2];
#pragma unroll
                for (int bj = 0; bj < 2; ++bj)
#pragma unroll
                    for (int n = 0; n < 2; ++n) bs[bj][n] = *(const u32x2v*)(hb + off + bj * HALF + n * 16);
#pragma unroll
                for (int bj = 0; bj < 2; ++bj)
#pragma unroll
                    for (int n = 0; n < 2; ++n) { const u32x2v b = bs[bj][n];
                        const f32x4 r = (f32x4){__builtin_bit_cast(float, b.x << 16), __builtin_bit_cast(float, b.x & 0xffff0000u), __builtin_bit_cast(float, b.y << 16), __builtin_bit_cast(float, b.y & 0xffff0000u)};
                        __builtin_nontemporal_store(r + acc[ai][bj][m][n], (f32x4*)(out + off + bj * HALF + n * 16)); } }
    }
};

template <class Epi, class Sched, bool ALIGN_EPI = false, bool SP2 = false>
__device__ __forceinline__ void gemm_phase(PG8_LAS unsigned char* lds, const Gemm g, const Sched& S, const Epi& E) {
    const int tid = threadIdx.x, wid = __builtin_amdgcn_readfirstlane(tid >> 6), lane = tid & 63, wr = wid >> 2, wc = wid & 3, fr = lane & 15, fq = lane >> 4;
    const int K = g.K, nt = K / BK;
    unsigned voffA[2], voffB[2];
#pragma unroll
    for (int i = 0; i < 2; ++i) { int R, C; stage_rc(tid * 16 + i * 8192, R, C); const int Rb = Epi::PERM ? ((R & ~31) + perm32(R & 31)) : R;
        voffA[i] = (unsigned)(R * K + C) * 2u; voffB[i] = (unsigned)(Rb * K + C) * 2u; }
    const size_t kstep = (size_t)(BK * 2);
    const size_t hstep = (size_t)HALF * K * 2;
    const size_t tstep = 2 * hstep;
    const unsigned ldsw = (unsigned)wid * 1024u;
    const int aoff = lds_byte(wr * 64 + fr, fq * 8), boff = lds_byte(wc * 32 + fr, fq * 8);
#define PG8_SA(b, h) (((b) * 2 + (h)) * HTB)
#define PG8_SB(b, h) ((4 + (b) * 2 + (h)) * HTB)
#define PG8_STAGE(bufoff, gbase, voff) do { _Pragma("unroll") for (int _i = 0; _i < 2; ++_i) \
        __builtin_amdgcn_global_load_lds((const unsigned*)((const char*)(gbase) + (voff)[_i]), (PG8_LAS unsigned*)(lds + (bufoff) + ldsw + _i * 8192), 16, 0, 0); } while (0)
#define PG8_LDA(dst, b, h) do { _Pragma("unroll") for (int m = 0; m < 4; ++m) _Pragma("unroll") for (int k = 0; k < 2; ++k) dst[m][k] = *(const PG8_LAS bf16x8*)(lds + PG8_SA(b, h) + aoff + m * 2048 + k * 1024); } while (0)
#define PG8_LDB(dst, b, h) do { _Pragma("unroll") for (int n = 0; n < 2; ++n) _Pragma("unroll") for (int k = 0; k < 2; ++k) dst[n][k] = *(const PG8_LAS bf16x8*)(lds + PG8_SB(b, h) + boff + n * 2048 + k * 1024); } while (0)
#define PG8_MMA(ai, bj, At, Bt) do { __builtin_amdgcn_s_setprio(1); _Pragma("unroll") for (int m = 0; m < 4; ++m) _Pragma("unroll") for (int n = 0; n < 2; ++n) _Pragma("unroll") for (int k = 0; k < 2; ++k) \
        acc[ai][bj][m][n] = __builtin_amdgcn_mfma_f32_16x16x32_bf16(Bt[n][k], At[m][k], acc[ai][bj][m][n], 0, 0, 0); __builtin_amdgcn_s_setprio(0); } while (0)
#define PG8_WAIT_V(n) asm volatile("s_waitcnt vmcnt(" #n ")" ::: "memory")
#define PG8_WAIT_L(n) asm volatile("s_waitcnt lgkmcnt(" #n ")" ::: "memory")
#define PG8_BAR __builtin_amdgcn_s_barrier()
#define PG8_SCHED __builtin_amdgcn_sched_barrier(0)
    Unit cur, nxt; int ui = 0;
    if (!S.next(0, cur)) return;
    f32x4 acc[2][2][4][2];
#pragma unroll
    for (int a = 0; a < 2; ++a)
#pragma unroll
        for (int b = 0; b < 2; ++b)
#pragma unroll
            for (int m = 0; m < 4; ++m)
#pragma unroll
                for (int n = 0; n < 2; ++n) acc[a][b][m][n] = (f32x4){0.f, 0.f, 0.f, 0.f};
    bf16x8 At[4][2], B0[2][2], B1[2][2];
    const char* cA = (const char*)g.A + (size_t)cur.pm * tstep; const char* cB = (const char*)g.Bt + (size_t)cur.pn * tstep;
    S.a_ready(cur);
    if constexpr (SP2) {
        PG8_STAGE(PG8_SB(0, 0), cB, voffB); PG8_STAGE(PG8_SB(0, 1), cB + hstep, voffB); PG8_STAGE(PG8_SA(0, 0), cA, voffA); PG8_STAGE(PG8_SA(0, 1), cA + hstep, voffA);
        if (wr == 1) PG8_BAR;
        PG8_WAIT_V(2); PG8_BAR;
        PG8_STAGE(PG8_SB(1, 0), cB + kstep, voffB); PG8_STAGE(PG8_SA(1, 0), cA + kstep, voffA); PG8_STAGE(PG8_SB(1, 1), cB + hstep + kstep, voffB);
        PG8_WAIT_V(6); PG8_BAR;
    } else {
        PG8_STAGE(PG8_SB(0, 0), cB, voffB); PG8_STAGE(PG8_SA(0, 0), cA, voffA); PG8_STAGE(PG8_SB(0, 1), cB + hstep, voffB); PG8_STAGE(PG8_SA(0, 1), cA + hstep, voffA);
        if (wr == 1) PG8_BAR;
        PG8_WAIT_V(4); PG8_BAR;
        PG8_STAGE(PG8_SB(1, 0), cB + kstep, voffB); PG8_STAGE(PG8_SA(1, 0), cA + kstep, voffA); PG8_STAGE(PG8_SB(1, 1), cB + hstep + kstep, voffB);
        PG8_WAIT_V(6); PG8_BAR;
    }
    for (;;) {
        const bool has_next = S.next(ui + 1, nxt);
        const char* nA = has_next ? (const char*)g.A + (size_t)nxt.pm * tstep : cA; const char* nB = has_next ? (const char*)g.Bt + (size_t)nxt.pn * tstep : cB;
        for (int t = 0; t < nt; t += 2) {
            const bool last = (t == nt - 2);
            const char* a1 = cA + (size_t)(t + 1) * kstep;
            const char* a2 = last ? nA : cA + (size_t)(t + 2) * kstep; const char* b2 = last ? nB : cB + (size_t)(t + 2) * kstep;
            const char* a3 = a2 + kstep; const char* b3 = b2 + kstep;
            if (last && has_next) S.a_ready(nxt);
            if constexpr (SP2) {
            PG8_LDB(B0, 0, 0); PG8_LDB(B1, 0, 1); PG8_SCHED; PG8_LDA(At, 0, 0); PG8_STAGE(PG8_SA(1, 1), a1 + hstep, voffA);
            PG8_WAIT_V(8); PG8_WAIT_L(0); PG8_BAR; PG8_MMA(0, 0, At, B0); PG8_MMA(0, 1, At, B1); PG8_BAR; PG8_SCHED;
            PG8_LDA(At, 0, 1); PG8_STAGE(PG8_SB(0, 0), b2, voffB); PG8_STAGE(PG8_SB(0, 1), b2 + hstep, voffB); PG8_STAGE(PG8_SA(0, 0), a2, voffA);
            PG8_WAIT_V(8); PG8_WAIT_L(0); PG8_BAR; PG8_MMA(1, 0, At, B0); PG8_MMA(1, 1, At, B1); PG8_BAR; PG8_SCHED;
            PG8_LDB(B0, 1, 0); PG8_LDB(B1, 1, 1); PG8_SCHED; PG8_LDA(At, 1, 0); PG8_STAGE(PG8_SA(0, 1), a2 + hstep, voffA);
            PG8_WAIT_V(8); PG8_WAIT_L(0); PG8_BAR; PG8_MMA(0, 0, At, B0); PG8_MMA(0, 1, At, B1); PG8_BAR; PG8_SCHED;
            PG8_LDA(At, 1, 1); PG8_STAGE(PG8_SB(1, 0), b3, voffB); PG8_STAGE(PG8_SB(1, 1), b3 + hstep, voffB); PG8_STAGE(PG8_SA(1, 0), a3, voffA);
            PG8_WAIT_V(8); PG8_WAIT_L(0); PG8_BAR; PG8_MMA(1, 0, At, B0); PG8_MMA(1, 1, At, B1); PG8_BAR; PG8_SCHED;
            } else {
            PG8_LDB(B0, 0, 0); PG8_SCHED; PG8_LDA(At, 0, 0); PG8_STAGE(PG8_SA(1, 1), a1 + hstep, voffA);
            PG8_WAIT_L(8); PG8_BAR; PG8_WAIT_L(0); PG8_MMA(0, 0, At, B0); PG8_BAR; PG8_SCHED;
            PG8_LDB(B1, 0, 1); PG8_STAGE(PG8_SB(0, 0), b2, voffB);
            PG8_BAR; PG8_WAIT_L(0); PG8_MMA(0, 1, At, B1); PG8_BAR;
            PG8_LDA(At, 0, 1); PG8_STAGE(PG8_SA(0, 0), a2, voffA);
            PG8_BAR; PG8_WAIT_L(0); PG8_MMA(1, 0, At, B0); PG8_BAR; PG8_SCHED;
            PG8_STAGE(PG8_SB(0, 1), b2 + hstep, voffB);
            PG8_WAIT_V(6); PG8_BAR; PG8_MMA(1, 1, At, B1); PG8_BAR;
            PG8_LDB(B0, 1, 0); PG8_SCHED; PG8_LDA(At, 1, 0); PG8_STAGE(PG8_SA(0, 1), a2 + hstep, voffA);
            PG8_WAIT_L(8); PG8_BAR; PG8_WAIT_L(0); PG8_MMA(0, 0, At, B0); PG8_BAR; PG8_SCHED;
            PG8_LDB(B1, 1, 1); PG8_STAGE(PG8_SB(1, 0), b3, voffB);
            PG8_BAR; PG8_WAIT_L(0); PG8_MMA(0, 1, At, B1); PG8_BAR;
            PG8_LDA(At, 1, 1); PG8_STAGE(PG8_SA(1, 0), a3, voffA);
            PG8_BAR; PG8_WAIT_L(0); PG8_MMA(1, 0, At, B0); PG8_BAR; PG8_SCHED;
            PG8_STAGE(PG8_SB(1, 1), b3 + hstep, voffB);
            PG8_WAIT_V(6); PG8_BAR; PG8_MMA(1, 1, At, B1); PG8_BAR;
            }
        }
        if constexpr (ALIGN_EPI) { if (wr == 0) PG8_BAR; }
        if constexpr (!Epi::AFTER_DRAIN) { E(acc, cur, wr, wc, fr, fq); S.done(cur); }
        if (!has_next) break;
#pragma unroll
        for (int a = 0; a < 2; ++a)
#pragma unroll
            for (int b = 0; b < 2; ++b)
#pragma unroll
                for (int m = 0; m < 4; ++m)
#pragma unroll
                    for (int n = 0; n < 2; ++n) acc[a][b][m][n] = (f32x4){0.f, 0.f, 0.f, 0.f};
        cur = nxt; cA = nA; cB = nB; ++ui;
        if constexpr (ALIGN_EPI) { if (wr == 1) PG8_BAR; }
    }
    PG8_WAIT_V(0);
    if constexpr (!ALIGN_EPI) { if (wr == 0) PG8_BAR; }
    PG8_BAR;
    if constexpr (Epi::AFTER_DRAIN) { E.fused(acc, cur, wr, wc, fr, fq, lds, wid, lane); S.done(cur); }
#undef PG8_SA
#undef PG8_SB
#undef PG8_STAGE
#undef PG8_LDA
#undef PG8_LDB
#undef PG8_MMA
#undef PG8_WAIT_V
#undef PG8_WAIT_L
#undef PG8_BAR
#undef PG8_SCHED
}
}

#ifndef PG8_SP2
#define PG8_SP2 true
#endif
#ifndef PG8_ALIGN
#define PG8_ALIGN true
#endif
#include <hip/hip_bf16.h>
#include <cmath>
namespace attn_body {
using bf16=__hip_bfloat16;
using bf16x8=__attribute__((ext_vector_type(8)))short;
using s16x4=__attribute__((ext_vector_type(4)))short;
using f32x16=__attribute__((ext_vector_type(16)))float;
using u32x4=__attribute__((ext_vector_type(4)))unsigned;
constexpr int SEQ=4096,D=64,DM=1024,OPITCH=2048;
constexpr int NW=8,QBLK=32,QB=128,KVBLK=64,NQB=SEQ/QB;
constexpr int ATTN_PITCH=DM, ATTN_UNIT_ROWS=QB;
__device__ __forceinline__ int crow(int r,int hi){return (r&3)+8*(r>>2)+4*hi;}
#define SBAR() __builtin_amdgcn_sched_barrier(0)
__device__ __forceinline__ void cmask(f32x16&p0,f32x16&p1,int jb,int qrel,int hi){
  const float NEG=-INFINITY; (void)hi;
  if(jb>(qrel>>6)){
  #pragma unroll
  for(int r=0;r<16;++r){p0[r]=NEG;p1[r]=NEG;} }
}

constexpr int NSLOT=3, KSLOT=4, SLOTB=8192;
constexpr int LDS_K=0, LDS_V=2*KSLOT*SLOTB, LDS_WS=LDS_V+2*NSLOT*SLOTB, LDS_OST=0  , LDS_BYTES=LDS_WS+NW*64*4;
constexpr float C2=0.125f*1.4426950408889634f;
__device__ __forceinline__ void glds16(const void*gsrc,unsigned lds_dst){unsigned keep;
  asm volatile("s_mov_b32 %0, m0\n\ts_mov_b32 m0, %2\n\ts_nop 0\n\tglobal_load_lds_dwordx4 %1, off\n\ts_mov_b32 m0, %0":"=&s"(keep):"v"(gsrc),"s"(lds_dst):"memory");}
__device__ __forceinline__ void glds16s(const void*sbase,unsigned voff,unsigned lds_dst){unsigned keep;
  asm volatile("s_mov_b32 %0, m0\n\ts_mov_b32 m0, %3\n\ts_nop 0\n\tglobal_load_lds_dwordx4 %1, %2\n\ts_mov_b32 m0, %0":"=&s"(keep):"v"(voff),"s"(sbase),"s"(lds_dst):"memory");}
__device__ __forceinline__ float max3f(float a,float b,float c){float r;asm("v_max3_f32 %0, %1, %2, %3":"=v"(r):"v"(a),"v"(b),"v"(c));return r;}
__device__ __forceinline__ float max2f(float a,float b){float r;asm("v_max_f32_e32 %0, %1, %2":"=v"(r):"v"(a),"v"(b));return r;}
__device__ __forceinline__ float fadd_s(float a,float b){float r;asm("v_add_f32_e32 %0, %1, %2":"=v"(r):"v"(a),"v"(b));return r;}
__device__ __forceinline__ float fsub_s(float a,float b){float r;asm("v_sub_f32_e32 %0, %1, %2":"=v"(r):"v"(a),"v"(b));return r;}
typedef float f32x2_t __attribute__((ext_vector_type(2))); typedef __bf16 bf16x2_t __attribute__((ext_vector_type(2)));
__device__ __forceinline__ unsigned cvtpk_s(float lo,float hi){f32x2_t v={lo,hi};bf16x2_t b=__builtin_convertvector(v,bf16x2_t);return __builtin_bit_cast(unsigned,b);}
#define WAIT_BAR(N) asm volatile("s_waitcnt vmcnt(" #N ") lgkmcnt(0)\n\ts_barrier":::"memory")

__device__ __forceinline__ void qkt(f32x16&p0,f32x16&p1,const char*Kslot,const bf16x8*qr,const f32x16&negm,int r32,int hi){
  const char*kb=Kslot+hi*1024+r32*16;
  #pragma unroll
  for(int d0=0;d0<4;++d0){
    const bf16x8 b0=*reinterpret_cast<const bf16x8*>(kb+d0*2048);
    const bf16x8 b1=*reinterpret_cast<const bf16x8*>(kb+d0*2048+512);
    if(d0==0){p0=__builtin_amdgcn_mfma_f32_32x32x16_bf16(b0,qr[0],negm,0,0,0);p1=__builtin_amdgcn_mfma_f32_32x32x16_bf16(b1,qr[0],negm,0,0,0);}
    else{p0=__builtin_amdgcn_mfma_f32_32x32x16_bf16(b0,qr[d0],p0,0,0,0);p1=__builtin_amdgcn_mfma_f32_32x32x16_bf16(b1,qr[d0],p1,0,0,0);}}
}
typedef __attribute__((address_space(3))) const char* lds_cptr;
typedef short v4i16_t __attribute__((ext_vector_type(4)));
__device__ __forceinline__ void kload8(bf16x8*kf,lds_cptr kp){
  kf[0]=*(const __attribute__((address_space(3))) bf16x8*)(kp);      kf[1]=*(const __attribute__((address_space(3))) bf16x8*)(kp+512);
  kf[2]=*(const __attribute__((address_space(3))) bf16x8*)(kp+2048); kf[3]=*(const __attribute__((address_space(3))) bf16x8*)(kp+2560);
  kf[4]=*(const __attribute__((address_space(3))) bf16x8*)(kp+4096); kf[5]=*(const __attribute__((address_space(3))) bf16x8*)(kp+4608);
  kf[6]=*(const __attribute__((address_space(3))) bf16x8*)(kp+6144); kf[7]=*(const __attribute__((address_space(3))) bf16x8*)(kp+6656);
}
__device__ __forceinline__ void kload2(bf16x8*kf,lds_cptr kp,int j){ kf[2*j]=*(const __attribute__((address_space(3))) bf16x8*)(kp+j*2048); kf[2*j+1]=*(const __attribute__((address_space(3))) bf16x8*)(kp+j*2048+512); }
__device__ __forceinline__ s16x4 vtr(lds_cptr p){ return __builtin_bit_cast(s16x4,__builtin_amdgcn_ds_read_tr16_b64_v4i16((__attribute__((address_space(3))) v4i16_t*)p)); }
__device__ __forceinline__ float rowmax(const f32x16&p0,const f32x16&p1){
  float a=max3f(p0[0],p0[1],p1[0]),b=max3f(p0[2],p0[3],p1[1]);a=max3f(a,p1[2],p1[3]);
  #pragma unroll
  for(int r=4;r<16;r+=4){a=max3f(a,p0[r],p0[r+1]);b=max3f(b,p0[r+2],p0[r+3]);a=max3f(a,p1[r],p1[r+1]);b=max3f(b,p1[r+2],p1[r+3]);}
  const float m=max2f(a,b);
  auto rr=__builtin_amdgcn_permlane32_swap(__float_as_uint(m),__float_as_uint(m),false,false);
  return max2f(__uint_as_float(rr[0]),__uint_as_float(rr[1]));
}
__device__ __forceinline__ void pv(f32x16*o,int vb,bf16x8 pa0,bf16x8 pa1,bf16x8 pa2,bf16x8 pa3){
  #pragma unroll
  for(int d0=0;d0<2;++d0){s16x4 lo[4],hi[4];
    #pragma unroll
    for(int ks=0;ks<4;++ks){
      asm volatile("ds_read_b64_tr_b16 %0,%1 offset:%c2":"=&v"(lo[ks]):"v"(vb),"i"(d0*4096+ks*1024):"memory");
      asm volatile("ds_read_b64_tr_b16 %0,%1 offset:%c2":"=&v"(hi[ks]):"v"(vb),"i"(d0*4096+ks*1024+512):"memory");}
    asm volatile("s_waitcnt lgkmcnt(0)":::"memory");SBAR();
    #define PK(k) (bf16x8){lo[k][0],lo[k][1],lo[k][2],lo[k][3],hi[k][0],hi[k][1],hi[k][2],hi[k][3]}
    o[d0]=__builtin_amdgcn_mfma_f32_32x32x16_bf16(pa0,PK(0),o[d0],0,0,0);
    o[d0]=__builtin_amdgcn_mfma_f32_32x32x16_bf16(pa1,PK(1),o[d0],0,0,0);
    o[d0]=__builtin_amdgcn_mfma_f32_32x32x16_bf16(pa2,PK(2),o[d0],0,0,0);
    o[d0]=__builtin_amdgcn_mfma_f32_32x32x16_bf16(pa3,PK(3),o[d0],0,0,0);
    #undef PK
  }
}

#ifndef ATTN_STORE16
#define ATTN_STORE16(p,v) (*(u32x4*)(p)=(v))
#endif
template<int THRL,bool SHF> __device__ __forceinline__ void attn_unit(int b,int h,int qb,int lin,float sh,const bf16*Q,const bf16*__restrict__ K,const bf16*__restrict__ V,bf16*MIXO,float lam,const float*__restrict__ subw,const bf16*__restrict__ CU,const bf16*__restrict__ CG,const float*__restrict__ convw,char*shm){
  const int tid=threadIdx.x,lane=tid&63,r32=lane&31,hi=lane>>5; const int wid=__builtin_amdgcn_readfirstlane(tid>>6);
  const int c=wid>>2,wq=wid&3;
  const long rowbase=(long)b*SEQ; const int q0=qb*QB;
  const bf16*Qw=Q+(rowbase+q0+wq*QBLK)*DM+h*128+c*64;
  const bf16*Kh=K+rowbase*DM+h*128,*Vh=V+rowbase*DM+h*128;
  const unsigned lds0=(unsigned)(uintptr_t)shm;
  float*wsf=(float*)(shm+LDS_WS)+wid*64;
  const unsigned koffb=(unsigned)(lane*DM+wid*8)*2u;
  const unsigned voffb=(unsigned)((16*(wid&3)+(lane>>2))*DM+(wid>>2)*32+(lane&3)*8)*2u;
  const unsigned kdst=lds0+LDS_K+wid*1024, vdst=lds0+LDS_V+wid*1024;
  #define DMA_K(t,slot) do{ glds16s(Kh+(long)(t)*KVBLK*DM,koffb,(unsigned)__builtin_amdgcn_readfirstlane(kdst+2*(slot))); glds16s(Kh+(long)(t)*KVBLK*DM+64,koffb,(unsigned)__builtin_amdgcn_readfirstlane(kdst+2*(slot)+8192)); }while(0)
  #define DMA_V(t,slot) do{ glds16s(Vh+(long)(t)*KVBLK*DM,voffb,(unsigned)__builtin_amdgcn_readfirstlane(vdst+2*(slot))); glds16s(Vh+(long)(t)*KVBLK*DM+64,voffb,(unsigned)__builtin_amdgcn_readfirstlane(vdst+2*(slot)+8192)); }while(0)
  const int vb0=(int)(lds0+LDS_V)+((lane>>4)&1)*32+(lane&3)*8+(4*hi+((lane&15)>>2))*64;
  const char*Kbase=shm+LDS_K+c*8192; bf16x8 kf[8];
  const lds_cptr shm3=(lds_cptr)shm; const lds_cptr kp0=shm3+LDS_K+c*8192+hi*1024+r32*16; const lds_cptr vp0=shm3+LDS_V+((lane>>4)&1)*32+(lane&3)*8+(4*hi+((lane&15)>>2))*64;
  const int NT=(q0+QB)/KVBLK;
  u32x4 cvu[2][3],cvg[2];
  #define CONV_LOAD(k0) do{ _Pragma("unroll") for(int k=0;k<2;++k){ const int item=lin*32+wid*4+(k0)+k,m=item>>1,col=(item&1)*512+lane*8,tt=m&(SEQ-1); \
    _Pragma("unroll") for(int j=0;j<3;++j){ const int dt=2-j; cvu[k][j]=(tt-dt>=0)?*(const u32x4*)(CU+(long)(m-dt)*1024+col):(u32x4){0u,0u,0u,0u}; } \
    cvg[k]=*(const u32x4*)(CG+(long)m*1024+col); } }while(0)
  #define CONV_FINISH(k0) do{ _Pragma("unroll") for(int k=0;k<2;++k){ const int item=lin*32+wid*4+(k0)+k,m=item>>1,col=(item&1)*512+lane*8; float ca[8]; \
    _Pragma("unroll") for(int i=0;i<8;++i)ca[i]=0.f; \
    _Pragma("unroll") for(int j=0;j<3;++j){ const float*wj=convw+j*1024+col; const unsigned uw[4]={cvu[k][j].x,cvu[k][j].y,cvu[k][j].z,cvu[k][j].w}; \
      _Pragma("unroll") for(int i=0;i<4;++i){ ca[2*i]+=wj[2*i]*__uint_as_float(uw[i]<<16); ca[2*i+1]+=wj[2*i+1]*__uint_as_float(uw[i]&0xffff0000u); } } \
    const unsigned gw_[4]={cvg[k].x,cvg[k].y,cvg[k].z,cvg[k].w}; u32x4 ov; \
    ov.x=cvtpk_s(ca[0]*__uint_as_float(gw_[0]<<16),ca[1]*__uint_as_float(gw_[0]&0xffff0000u)); ov.y=cvtpk_s(ca[2]*__uint_as_float(gw_[1]<<16),ca[3]*__uint_as_float(gw_[1]&0xffff0000u)); \
    ov.z=cvtpk_s(ca[4]*__uint_as_float(gw_[2]<<16),ca[5]*__uint_as_float(gw_[2]&0xffff0000u)); ov.w=cvtpk_s(ca[6]*__uint_as_float(gw_[3]<<16),ca[7]*__uint_as_float(gw_[3]&0xffff0000u)); \
    *(u32x4*)(MIXO+(long)m*OPITCH+1024+col)=ov; } }while(0)
  CONV_LOAD(0);
  DMA_K(0,0);DMA_V(0,0);DMA_K(1,SLOTB);
  bf16x8 qr[4];
  #pragma unroll
  for(int d0=0;d0<4;++d0)qr[d0]=*reinterpret_cast<const bf16x8*>(&Qw[(long)r32*DM+d0*16+hi*8]);
  float l_reg=0.f;f32x16 o[4];o[0]=f32x16{};o[1]=f32x16{};o[2]=f32x16{};o[3]=f32x16{};const f32x16 zero16=f32x16{};
  const int qrel=wq*QBLK+r32;
  #define CMASK(P0,P1,t) do{int jb_=(t)-(NT-2); if(jb_>=0)cmask(P0,P1,jb_,qrel,hi);}while(0)
  f32x16 C0,C1;
  int sl_prev=0,sl_cur=0,sl_next=SLOTB;
  int ks_prev=3*SLOTB,ks_cur=0,ks_next=SLOTB;
  #define ROT() do{sl_prev=sl_cur;sl_cur=sl_next;sl_next=(sl_next==(NSLOT-1)*SLOTB)?0:sl_next+SLOTB; ks_prev=ks_cur;ks_cur=ks_next;ks_next=(ks_next==(KSLOT-1)*SLOTB)?0:ks_next+SLOTB;}while(0)
  DMA_K(2,2*SLOTB);
  WAIT_BAR(6);
  s16x4 vlo[8],vhi[8]; u32x4 pa0,pa1,pa2,pa3,pb0,pb1,pb2,pb3;
  #define PKW(P,B) cvtpk_s(P[B],P[B+1])
  CONV_FINISH(0); CONV_LOAD(2);
  qkt(C0,C1,Kbase,qr,zero16,r32,hi);asm volatile("s_nop 15\n\ts_nop 7":"+v"(C0),"+v"(C1));CMASK(C0,C1,0);
  #define SHX(v) (SHF?(v)-sh:(v))
  _Pragma("unroll") for(int r=0;r<16;++r){C0[r]=__builtin_amdgcn_exp2f(SHX(C0[r]));C1[r]=__builtin_amdgcn_exp2f(SHX(C1[r]));}
  { float sacc=C0[0]+C0[1]; _Pragma("unroll") for(int r=2;r<16;++r)sacc+=C0[r]; _Pragma("unroll") for(int r=0;r<16;++r)sacc+=C1[r]; l_reg+=sacc;
    pa0=(u32x4){PKW(C0,0),PKW(C0,2),PKW(C0,4),PKW(C0,6)};pa1=(u32x4){PKW(C0,8),PKW(C0,10),PKW(C0,12),PKW(C0,14)};pa2=(u32x4){PKW(C1,0),PKW(C1,2),PKW(C1,4),PKW(C1,6)};pa3=(u32x4){PKW(C1,8),PKW(C1,10),PKW(C1,12),PKW(C1,14)}; }
  WAIT_BAR(0);
  CONV_FINISH(2);
  #undef CONV_LOAD
  #undef CONV_FINISH
  DMA_K(3,3*SLOTB);DMA_V(1,SLOTB);
  ROT();
  { const lds_cptr kp_=kp0+2*ks_cur; kf[0]=*(const __attribute__((address_space(3))) bf16x8*)(kp_); kf[2]=*(const __attribute__((address_space(3))) bf16x8*)(kp_+2048); }
  if(NT==2){WAIT_BAR(0);}else{WAIT_BAR(4);}
  #define BC8(x) __builtin_bit_cast(bf16x8,x)
  #define VFR(i) (bf16x8){vlo[i][0],vlo[i][1],vlo[i][2],vlo[i][3],vhi[i][0],vhi[i][1],vhi[i][2],vhi[i][3]}
  #define PIN(x) asm volatile("":"+v"(x))
  #define MX3(a,b,c) __builtin_fmaxf(__builtin_fmaxf((a),(b)),(c))
  #define EX(v) __builtin_amdgcn_exp2f(v)
  #define MF(a,b,c) __builtin_amdgcn_mfma_f32_32x32x16_bf16(a,b,c,0,0,0)
  #define VRDH(i,h) do{ vlo[i]=vtr(vp_+((h)*8192+((i)>>2)*4096+((i)&3)*1024)); vhi[i]=vtr(vp_+((h)*8192+((i)>>2)*4096+((i)&3)*1024+512)); }while(0)
  #define KRD(G,j) do{ if(G){ kload2(kf,kp0+2*ks_next,j); } }while(0)
  #define GAPB(D,MF_,RD_,X,B,PW,e) do{ MF_; PIN(o[D]); RD_; X[B]=EX(SHX(X[B])); X[B+1]=EX(SHX(X[B+1])); sacc+=X[B]; sacc+=X[B+1]; PW[e]=cvtpk_s(X[B],X[B+1]); PIN(X); PIN(sacc); PIN(PW); SBAR(); }while(0)
  #define KLD(i) kf[i]=*(const __attribute__((address_space(3))) bf16x8*)(kp_+((i)>>1)*2048+((i)&1)*512)
  #define KLDN(i) do{ if(gl_){ kf[i]=*(const __attribute__((address_space(3))) bf16x8*)(kn_+((i)>>1)*2048+((i)&1)*512); } }while(0)
  #define STEP(PP0,PP1,PP2,PP3,PN0,PN1,PN2,PN3,t,GK,GV,GL) do{ SBAR(); \
    const lds_cptr vp_=vp0+2*sl_prev; const lds_cptr kp_=kp0+2*ks_cur; const lds_cptr kn_=kp0+2*ks_next; const bool gl_=(GL); float sacc=0.f; \
    KLD(4); KLD(6); VRDH(0,0); SBAR(); C0=MF(kf[0],qr[0],zero16); SBAR(); \
    KLD(1); KLD(3); VRDH(4,0); SBAR(); C0=MF(kf[2],qr[1],C0); SBAR(); \
    KLD(5); KLD(7); VRDH(1,0); SBAR(); C0=MF(kf[4],qr[2],C0); SBAR(); \
    VRDH(5,0); SBAR(); C0=MF(kf[6],qr[3],C0); PIN(C0); SBAR(); \
    CMASK(C0,C0,t); \
    C1=MF(kf[1],qr[0],zero16); PIN(C1); VRDH(2,0); C0[0]=EX(SHX(C0[0])); C0[1]=EX(SHX(C0[1])); C0[2]=EX(SHX(C0[2])); C0[3]=EX(SHX(C0[3])); sacc+=C0[0]; sacc+=C0[1]; sacc+=C0[2]; sacc+=C0[3]; PN0[0]=cvtpk_s(C0[0],C0[1]); PN0[1]=cvtpk_s(C0[2],C0[3]); PIN(C0); PIN(sacc); PIN(PN0); SBAR(); \
    C1=MF(kf[3],qr[1],C1); PIN(C1); VRDH(6,0); C0[4]=EX(SHX(C0[4])); C0[5]=EX(SHX(C0[5])); C0[6]=EX(SHX(C0[6])); C0[7]=EX(SHX(C0[7])); sacc+=C0[4]; sacc+=C0[5]; sacc+=C0[6]; sacc+=C0[7]; PN0[2]=cvtpk_s(C0[4],C0[5]); PN0[3]=cvtpk_s(C0[6],C0[7]); PIN(C0); PIN(sacc); PIN(PN0); SBAR(); \
    C1=MF(kf[5],qr[2],C1); PIN(C1); VRDH(3,0); C0[8]=EX(SHX(C0[8])); C0[9]=EX(SHX(C0[9])); C0[10]=EX(SHX(C0[10])); C0[11]=EX(SHX(C0[11])); sacc+=C0[8]; sacc+=C0[9]; sacc+=C0[10]; sacc+=C0[11]; PN1[0]=cvtpk_s(C0[8],C0[9]); PN1[1]=cvtpk_s(C0[10],C0[11]); PIN(C0); PIN(sacc); PIN(PN1); SBAR(); \
    C1=MF(kf[7],qr[3],C1); PIN(C1); VRDH(7,0); C0[12]=EX(SHX(C0[12])); C0[13]=EX(SHX(C0[13])); C0[14]=EX(SHX(C0[14])); C0[15]=EX(SHX(C0[15])); sacc+=C0[12]; sacc+=C0[13]; sacc+=C0[14]; sacc+=C0[15]; PN1[2]=cvtpk_s(C0[12],C0[13]); PN1[3]=cvtpk_s(C0[14],C0[15]); PIN(C0); PIN(sacc); PIN(PN1); SBAR(); \
    if(GK){DMA_K((t)+3,ks_prev);} if(GV){DMA_V((t)+1,sl_next);} \
    CMASK(C1,C1,t); \
    SBAR(); \
    o[0]=MF(BC8(PP0),VFR(0),o[0]); PIN(o[0]); VRDH(0,1); C1[0]=EX(SHX(C1[0])); sacc+=C1[0]; PIN(C1); PIN(sacc); SBAR(); \
    o[1]=MF(BC8(PP0),VFR(4),o[1]); PIN(o[1]); VRDH(4,1); C1[1]=EX(SHX(C1[1])); sacc+=C1[1]; PN2[0]=cvtpk_s(C1[0],C1[1]); PIN(PN2); PIN(C1); PIN(sacc); SBAR(); \
    o[0]=MF(BC8(PP1),VFR(1),o[0]); PIN(o[0]); VRDH(1,1); C1[2]=EX(SHX(C1[2])); sacc+=C1[2]; PIN(C1); PIN(sacc); SBAR(); \
    o[1]=MF(BC8(PP1),VFR(5),o[1]); PIN(o[1]); VRDH(5,1); C1[3]=EX(SHX(C1[3])); sacc+=C1[3]; PN2[1]=cvtpk_s(C1[2],C1[3]); PIN(PN2); PIN(C1); PIN(sacc); SBAR(); \
    o[0]=MF(BC8(PP2),VFR(2),o[0]); PIN(o[0]); VRDH(2,1); C1[4]=EX(SHX(C1[4])); sacc+=C1[4]; PIN(C1); PIN(sacc); SBAR(); \
    o[1]=MF(BC8(PP2),VFR(6),o[1]); PIN(o[1]); VRDH(6,1); C1[5]=EX(SHX(C1[5])); sacc+=C1[5]; PN2[2]=cvtpk_s(C1[4],C1[5]); PIN(PN2); PIN(C1); PIN(sacc); SBAR(); \
    o[0]=MF(BC8(PP3),VFR(3),o[0]); PIN(o[0]); VRDH(3,1); C1[6]=EX(SHX(C1[6])); sacc+=C1[6]; PIN(C1); PIN(sacc); SBAR(); \
    o[1]=MF(BC8(PP3),VFR(7),o[1]); PIN(o[1]); VRDH(7,1); C1[7]=EX(SHX(C1[7])); sacc+=C1[7]; PN2[3]=cvtpk_s(C1[6],C1[7]); PIN(PN2); PIN(C1); PIN(sacc); SBAR(); \
    o[2]=MF(BC8(PP0),VFR(0),o[2]); PIN(o[2]); (void)0; C1[8]=EX(SHX(C1[8])); sacc+=C1[8]; PIN(C1); PIN(sacc); SBAR(); \
    o[3]=MF(BC8(PP0),VFR(4),o[3]); PIN(o[3]); (void)0; C1[9]=EX(SHX(C1[9])); sacc+=C1[9]; PN3[0]=cvtpk_s(C1[8],C1[9]); PIN(PN3); PIN(C1); PIN(sacc); SBAR(); \
    o[2]=MF(BC8(PP1),VFR(1),o[2]); PIN(o[2]); (void)0; C1[10]=EX(SHX(C1[10])); sacc+=C1[10]; PIN(C1); PIN(sacc); SBAR(); \
    o[3]=MF(BC8(PP1),VFR(5),o[3]); PIN(o[3]); (void)0; C1[11]=EX(SHX(C1[11])); sacc+=C1[11]; PN3[1]=cvtpk_s(C1[10],C1[11]); PIN(PN3); PIN(C1); PIN(sacc); SBAR(); \
    o[2]=MF(BC8(PP2),VFR(2),o[2]); PIN(o[2]); (void)0; C1[12]=EX(SHX(C1[12])); sacc+=C1[12]; PIN(C1); PIN(sacc); SBAR(); \
    o[3]=MF(BC8(PP2),VFR(6),o[3]); PIN(o[3]); KLDN(0); C1[13]=EX(SHX(C1[13])); sacc+=C1[13]; PN3[2]=cvtpk_s(C1[12],C1[13]); PIN(PN3); PIN(C1); PIN(sacc); SBAR(); \
    o[2]=MF(BC8(PP3),VFR(3),o[2]); PIN(o[2]); (void)0; C1[14]=EX(SHX(C1[14])); sacc+=C1[14]; PIN(C1); PIN(sacc); SBAR(); \
    o[3]=MF(BC8(PP3),VFR(7),o[3]); PIN(o[3]); KLDN(2); C1[15]=EX(SHX(C1[15])); sacc+=C1[15]; PN3[3]=cvtpk_s(C1[14],C1[15]); PIN(PN3); PIN(C1); PIN(sacc); SBAR(); \
    l_reg+=sacc; \
    }while(0)
  #define STEP_AB(t,GK,GV,GL) STEP(pa0,pa1,pa2,pa3,pb0,pb1,pb2,pb3,t,GK,GV,GL)
  #define STEP_BA(t,GK,GV,GL) STEP(pb0,pb1,pb2,pb3,pa0,pa1,pa2,pa3,t,GK,GV,GL)
  int t=1;
  #undef CMASK
  #define CMASK(P0,P1,t) do{}while(0)
  for(;t+5<NT;t+=2){
    STEP_AB(t,true,true,true);     WAIT_BAR(4); ROT();
    STEP_BA(t+1,true,true,true);   WAIT_BAR(4); ROT();
  }
  #undef CMASK
  #define CMASK(P0,P1,t) do{int jb_=(t)-(NT-2); if(jb_>=0)cmask(P0,P1,jb_,qrel,hi);}while(0)
  #define ENDW(tt) do{ if((tt)+3<NT){WAIT_BAR(4);} else if((tt)+2<NT){WAIT_BAR(2);} else {WAIT_BAR(0);} }while(0)
  for(;t+1<NT;t+=2){
    STEP_AB(t,(t+3<NT),(t+1<NT),(t+1<NT));       ENDW(t);   ROT();
    STEP_BA(t+1,(t+4<NT),(t+2<NT),(t+2<NT));     ENDW(t+1); ROT();
  }
  STEP_AB(NT-1,false,false,false);
  SBAR(); pv(o,vb0+2*sl_cur,BC8(pb0),BC8(pb1),BC8(pb2),BC8(pb3)); pv(o+2,vb0+2*sl_cur+8192,BC8(pb0),BC8(pb1),BC8(pb2),BC8(pb3));
  #undef PKW
  #undef BC8
  #undef VFR
  #undef PIN
  #undef MX3
  #undef GAPB
  #undef EX
  #undef MF
  #undef VRDH
  #undef KRD
  #undef KLD
  #undef KLDN
  #undef STEP
  #undef STEP_AB
  #undef STEP_BA
  #undef ENDW
  {auto rr=__builtin_amdgcn_permlane32_swap(__float_as_uint(l_reg),__float_as_uint(l_reg),false,false);l_reg=__uint_as_float(rr[0])+__uint_as_float(rr[1]);}
  if(hi==0)wsf[32+r32]=l_reg;asm volatile("s_waitcnt lgkmcnt(0)":::"memory");
  float rli[16];
  #pragma unroll
  for(int r=0;r<16;++r)rli[r]=__builtin_amdgcn_rcpf(wsf[32+crow(r,hi)]);
  asm volatile("s_waitcnt vmcnt(0) lgkmcnt(0)\n\ts_barrier":::"memory");
  { bf16*stg=(bf16*)(shm+LDS_OST)+wid*4096;
    #pragma unroll
    for(int r=0;r<16;++r){const int orow=crow(r,hi);
      #pragma unroll
      for(int d0=0;d0<4;++d0)stg[orow*128+d0*32+r32]=__float2bfloat16(o[d0][r]*rli[r]);} }
  asm volatile("s_waitcnt lgkmcnt(0)\n\ts_barrier":::"memory");
  { const bf16*st0=(const bf16*)(shm+LDS_OST);
    #pragma unroll
    for(int pss=0;pss<4;++pss){ const int row=wid*16+pss*4+(lane>>4),e=(lane&15)*8;
      const u32x4 a=*(const u32x4*)(st0+((row>>5)*4096+(row&31)*128+e)), bq=*(const u32x4*)(st0+((4+(row>>5))*4096+(row&31)*128+e));
      float d[8]; const unsigned aw[4]={a.x,a.y,a.z,a.w},bw[4]={bq.x,bq.y,bq.z,bq.w};
      #pragma unroll
      for(int i=0;i<4;++i){ d[2*i]=__uint_as_float(aw[i]<<16)-lam*__uint_as_float(bw[i]<<16); d[2*i+1]=__uint_as_float(aw[i]&0xffff0000u)-lam*__uint_as_float(bw[i]&0xffff0000u); }
      float ss=0.f;
      #pragma unroll
      for(int i=0;i<8;++i)ss+=d[i]*d[i];
      ss+=__shfl_xor(ss,1);ss+=__shfl_xor(ss,2);ss+=__shfl_xor(ss,4);ss+=__shfl_xor(ss,8);
      const float rstd=(1.f/sqrtf(ss*(1.f/128.f)+1e-5f))*0.8f;
      const float*sw=subw+e; u32x4 ov;
      ov.x=cvtpk_s(d[0]*rstd*sw[0],d[1]*rstd*sw[1]);ov.y=cvtpk_s(d[2]*rstd*sw[2],d[3]*rstd*sw[3]);ov.z=cvtpk_s(d[4]*rstd*sw[4],d[5]*rstd*sw[5]);ov.w=cvtpk_s(d[6]*rstd*sw[6],d[7]*rstd*sw[7]);
      ATTN_STORE16(MIXO+(rowbase+q0+row)*OPITCH+h*128+e,ov); } }
  asm volatile("s_waitcnt lgkmcnt(0)\n\ts_barrier":::"memory");
  #undef DMA_K
  #undef DMA_V
  #undef CMASK
  #undef SHX
  #undef ROT
}
constexpr int ATTN_LDS_BYTES=LDS_BYTES;
struct AttnTensors { const bf16* Q; const bf16* K; const bf16* V; bf16* MIX; float lam; float sh; const float* subw; const bf16* U; const bf16* GB; const float* convw; };
struct AttnUnit { int bh; int qb; int lin; };
struct StaticOrder {
  int vcu, G;
  __device__ __forceinline__ explicit StaticOrder(int grid,int block):vcu((grid%8==0)?(block%8)*(grid/8)+block/8:block),G(grid){}
  __device__ __forceinline__ bool next(int i,AttnUnit&u)const{
    if(G==256){ if(i>=2)return false; const int s=vcu&15; u.bh=vcu>>4; u.qb=(i&1)?31-s:s; u.lin=2*vcu+i; return true; }
    const int L=i*G+vcu; if(L>=16*NQB)return false; u.bh=L/NQB; u.qb=L%NQB; u.lin=L; return true; }
  __device__ __forceinline__ void a_ready(const AttnUnit&)const{}
  __device__ __forceinline__ void done(const AttnUnit&)const{}
};
template<class Sched,int THRL=8> __device__ __forceinline__ void attn_phase(char*lds,const AttnTensors&T,const Sched&S){
  AttnUnit u;
  if(__builtin_expect(T.sh==0.f,1)){ for(int i=0;S.next(i,u);++i){ S.a_ready(u); attn_unit<THRL,false>(u.bh>>3,u.bh&7,u.qb,u.lin,0.f,T.Q,T.K,T.V,T.MIX,T.lam,T.subw,T.U,T.GB,T.convw,lds); S.done(u); } }
  else { for(int i=0;S.next(i,u);++i){ S.a_ready(u); attn_unit<THRL,true>(u.bh>>3,u.bh&7,u.qb,u.lin,T.sh,T.Q,T.K,T.V,T.MIX,T.lam,T.subw,T.U,T.GB,T.convw,lds); S.done(u); } }
}
#undef SBAR
#undef WAIT_BAR
}
#include <hip/hip_cooperative_groups.h>
namespace cg = cooperative_groups;

constexpr int NWAVES = 8;
#ifndef MK_N_LAUNCHES
#define MK_N_LAUNCHES 1
#endif
constexpr int N_LAUNCHES = MK_N_LAUNCHES, N_PHASES = 9;

constexpr int BATCH = 2, SEQ = 4096, DMODEL = 2048, M = BATCH * SEQ;
constexpr int NH = 8, AW = 1024, CWID = 1024, INC = 6144, DFF = 5632;
constexpr float RMS_EPS = 1e-6f, SUBLN_EPS = 1e-5f, LAM_INIT = 0.2f;
constexpr size_t MiB = 1u << 20;
constexpr size_t WS_SS = 0;
constexpr size_t WS_ROPE = 1 * MiB;
constexpr size_t WS_WIN = 2 * MiB, WS_WOUT = 26 * MiB, WS_WGU = 34 * MiB, WS_WDN = 78 * MiB;
constexpr size_t WS_XN = 100 * MiB;
constexpr size_t WS_Q = 132 * MiB, WS_K = 148 * MiB, WS_V = 164 * MiB, WS_GB = 180 * MiB, WS_GC = 196 * MiB, WS_HC = 212 * MiB;
constexpr size_t WS_MIX = 212 * MiB;
constexpr size_t WS_H1 = 132 * MiB;
constexpr size_t WS_H = 164 * MiB;
constexpr size_t WS_BAR = 252 * MiB, BAR_BYTES = 16384;
constexpr size_t WS_RS = 252 * MiB + BAR_BYTES;
constexpr size_t WS_END = WS_RS + (size_t)M * 4;
static_assert(WS_WIN + (size_t)INC * DMODEL * 2 <= WS_WOUT && WS_WOUT + (size_t)DMODEL * DMODEL * 2 <= WS_WGU && WS_WGU + (size_t)2 * DFF * DMODEL * 2 <= WS_WDN && WS_WDN + (size_t)DMODEL * DFF * 2 <= WS_XN, "weights map");
static_assert(WS_XN + (size_t)M * DMODEL * 2 <= WS_Q && WS_HC + (size_t)M * 1024 * 2 <= WS_BAR && WS_H + (size_t)M * DFF * 2 <= WS_BAR && WS_H1 + (size_t)M * DMODEL * 2 <= WS_H, "activation map");
constexpr int RING_BYTES = 131072, LDS_BYTES = 147456;
static_assert(attn_body::ATTN_LDS_BYTES <= RING_BYTES && pg8::STAGE_BYTES <= RING_BYTES, "LDS map");

#define GAS __attribute__((address_space(1)))
#define LAS __attribute__((address_space(3)))
typedef unsigned short bf16;
typedef unsigned v4u __attribute__((ext_vector_type(4)));
typedef float f32x4 __attribute__((ext_vector_type(4)));
typedef float f32x2 __attribute__((ext_vector_type(2)));
#define LDS_WAIT() asm volatile("s_waitcnt lgkmcnt(0)" ::: "memory")
__device__ __forceinline__ unsigned f2bf(float f) { unsigned u = __builtin_bit_cast(unsigned, f); return (u + 0x7fffu + ((u >> 16) & 1u)) >> 16; }
__device__ __forceinline__ unsigned pk2(float lo, float hi) { return f2bf(lo) | (f2bf(hi) << 16); }
__device__ __forceinline__ float bf_lo(unsigned w) { return __builtin_bit_cast(float, w << 16); }
__device__ __forceinline__ float bf_hi(unsigned w) { return __builtin_bit_cast(float, w & 0xffff0000u); }
__device__ __forceinline__ float wave_sum(float v) {
#pragma unroll
    for (int o = 1; o < 64; o <<= 1) v += __shfl_xor(v, o);
    return v;
}
__device__ __forceinline__ void p0_transpose_tile(const float* W, int N, int k0, int n0, bf16* WT, int K, int drow0, LAS float* scr, int lane, const float* kscale = nullptr) {
    float tv[32];
#pragma unroll
    for (int i = 0; i < 32; ++i) tv[i] = __builtin_nontemporal_load(W + (size_t)(k0 + 2 * i + (lane >> 5)) * N + n0 + (lane & 31));
#pragma unroll
    for (int i = 0; i < 32; ++i) scr[(2 * i + (lane >> 5)) * 33 + (lane & 31)] = kscale ? tv[i] * kscale[k0 + 2 * i + (lane >> 5)] : tv[i];
    LDS_WAIT(); asm volatile("" ::: "memory");
    const int c = lane & 7;
#pragma unroll
    for (int j = 0; j < 4; ++j) { const int n = (lane >> 3) + 8 * j; const LAS float* s = scr + (8 * c) * 33 + n;
        v4u o; o.x = pk2(s[0 * 33], s[1 * 33]); o.y = pk2(s[2 * 33], s[3 * 33]); o.z = pk2(s[4 * 33], s[5 * 33]); o.w = pk2(s[6 * 33], s[7 * 33]);
        *(GAS v4u*)(WT + (size_t)(drow0 + n) * K + k0 + 8 * c) = o; }
    LDS_WAIT(); asm volatile("" ::: "memory");
}
__device__ __forceinline__ void x_row_to_bf16(const float* xrow, bf16* orow, float* rs, int lane) {
    const GAS f32x4* xr = (const GAS f32x4*)xrow + lane; f32x4 v[8]; float s = 0.f;
#pragma unroll
    for (int j = 0; j < 8; ++j) { v[j] = __builtin_nontemporal_load(xr + 64 * j); s += (v[j].x * v[j].x + v[j].y * v[j].y) + (v[j].z * v[j].z + v[j].w * v[j].w); }
    const float rstd = 1.f / sqrtf(wave_sum(s) * (1.f / DMODEL) + RMS_EPS); if (lane == 0) *rs = rstd;
    GAS unsigned long long* o8 = (GAS unsigned long long*)orow + lane;
#pragma unroll
    for (int j = 0; j < 8; ++j) o8[64 * j] = (unsigned long long)pk2(v[j].x, v[j].y) | ((unsigned long long)pk2(v[j].z, v[j].w) << 32);
}
__device__ __forceinline__ void rms_row_to_bf16(const float* xrow, const float* w, bf16* orow, int lane) {
    const GAS f32x4* xr = (const GAS f32x4*)xrow + lane; const GAS f32x4* wr = (const GAS f32x4*)w + lane;
    f32x4 v[8]; float s = 0.f;
#pragma unroll
    for (int j = 0; j < 8; ++j) { v[j] = __builtin_nontemporal_load(xr + 64 * j); s +=     (v[j].x * v[j].x + v[j].y * v[j].y) + (v[j].z * v[j].z + v[j].w * v[j].w); }
    const float rstd = 1.f / sqrtf(wave_sum(s) * (1.f / DMODEL) + RMS_EPS);
    GAS unsigned long long* o8 = (GAS unsigned long long*)orow + lane;
#pragma unroll
    for (int j = 0; j < 8; ++j) { const f32x4 ww = wr[64 * j];
        o8[64 * j] = (unsigned long long)pk2(v[j].x * rstd * ww.x, v[j].y * rstd * ww.y) | ((unsigned long long)pk2(v[j].z * rstd * ww.z, v[j].w * rstd * ww.w) << 32); }
}

#define XB_TMO      128
#define XB_XCNT(j)  (256  + 64 * (j))
#define XB_XSUB(j)  (1280 + 64 * (j))
#define XB_XGEN(j)  (2304 + 64 * (j))
#define XB_TOP      3328
#define XB_TOPGEN   3392
#define XCD_BAR_WORDS 3456
#define XB_SPIN_CAP (1u << 18)

__device__ __forceinline__ unsigned xb_ld(unsigned* p)              { return __hip_atomic_load(p, __ATOMIC_RELAXED, __HIP_MEMORY_SCOPE_AGENT); }
__device__ __forceinline__ unsigned xb_add(unsigned* p, unsigned v) { return __hip_atomic_fetch_add(p, v, __ATOMIC_RELAXED, __HIP_MEMORY_SCOPE_AGENT); }
__device__ __forceinline__ unsigned xb_xcc_id() { return (unsigned)__builtin_amdgcn_s_getreg((3 << 11) | 20) & 0xFu; }
#define XB_SPIN(cond, bar) do { unsigned _sp = 0; while (cond) { __builtin_amdgcn_s_sleep(1); \
    if ((++_sp & 255u) == 0u) { if (xb_ld(&(bar)[XB_TMO])) break; if (_sp > XB_SPIN_CAP) { atomicAdd(&(bar)[XB_TMO], 1u); break; } } } } while (0)

struct XcdBarrier {
    unsigned* bar; unsigned x;
    volatile LAS unsigned* st;
};

__device__ __forceinline__ XcdBarrier xcd_barrier_post(unsigned* bar, volatile LAS unsigned* st) {
    XcdBarrier b; b.bar = bar; b.x = xb_xcc_id(); b.st = st;
    if (threadIdx.x == 0) (void)xb_add(&bar[XB_XCNT(b.x)], 1u);
    return b;
}
__device__ __forceinline__ void xcd_barrier_complete(unsigned* bar, unsigned x, unsigned& nloc, unsigned& nx) {
    const unsigned G = gridDim.x * gridDim.y * gridDim.z;
    unsigned sum, cnt, mine, sp = 0u;
    for (;;) {
        sum = 0u; cnt = 0u; mine = 0u;
#pragma unroll
        for (unsigned j = 0; j < 16; ++j) { const unsigned c = xb_ld(&bar[XB_XCNT(j)]); sum += c; cnt += (c > 0u) ? 1u : 0u; mine = (j == x) ? c : mine; }
        if (sum == G) break;
        __builtin_amdgcn_s_sleep(1);
        if ((++sp & 255u) == 0u) { if (xb_ld(&bar[XB_TMO])) break; if (sp > XB_SPIN_CAP) { atomicAdd(&bar[XB_TMO], 1u); break; } }
    }
    nloc = mine > 0u ? mine : 1u; nx = cnt > 0u ? cnt : 1u;
}

__device__ __forceinline__ void xcd_barrier(const XcdBarrier& b) {
    asm volatile("s_waitcnt vmcnt(0)" ::: "memory");
    __syncthreads();
    if (threadIdx.x == 0) {
        unsigned* bar = b.bar;
        __builtin_amdgcn_s_waitcnt(0);
        unsigned nloc = b.st[0], nx = b.st[1];
        if (nloc == 0u) { xcd_barrier_complete(bar, b.x, nloc, nx); b.st[0] = nloc; b.st[1] = nx; }
        const unsigned old = xb_add(&bar[XB_XSUB(b.x)], 1u);
        const unsigned gen = old / nloc;
        if (old + 1u == (gen + 1u) * nloc) {
            __builtin_amdgcn_fence(__ATOMIC_RELEASE, "agent");
            asm volatile("s_waitcnt vmcnt(0)" ::: "memory");
            const unsigned og = xb_add(&bar[XB_TOP], 1u);
            const unsigned tg = og / nx;
            if (og + 1u == (tg + 1u) * nx) xb_add(&bar[XB_TOPGEN], 1u);
            else XB_SPIN(xb_ld(&bar[XB_TOPGEN]) == tg, bar);
            __builtin_amdgcn_fence(__ATOMIC_ACQUIRE, "agent");
            xb_add(&bar[XB_XGEN(b.x)], 1u);
            asm volatile("s_waitcnt vmcnt(0)" ::: "memory");
        } else {
            XB_SPIN(xb_ld(&bar[XB_XGEN(b.x)]) == gen, bar);
            __builtin_amdgcn_fence(__ATOMIC_ACQUIRE, "agent");
            asm volatile("s_waitcnt vmcnt(0)" ::: "memory");
        }
    }
    __syncthreads();
}

struct Args { const float* in[16]; float* out; unsigned char* ws; int ph_lo, ph_hi; };

__global__ void __launch_bounds__(NWAVES * 64, 2) block_fwd(Args args) {
    extern __shared__ __attribute__((aligned(16))) unsigned char lds[];
    cg::grid_group grid = cg::this_grid();
    const int tid = threadIdx.x, lane = tid & 63, wave = __builtin_amdgcn_readfirstlane(tid >> 6);
    const int G = gridDim.x; const int bx = blockIdx.x; const int vcu = (G % 8 == 0) ? (bx % 8) * (G / 8) + bx / 8 : bx;
    const int gw = vcu * NWAVES + wave, NGW = G * NWAVES;
    LAS unsigned char* ldsl = (LAS unsigned char*)lds;
    unsigned char* ws = args.ws;
    const float* x = args.in[0]; const float* attn_norm_w = args.in[1]; const float* w_in = args.in[2]; const float* q_norm_w = args.in[3]; const float* k_norm_w = args.in[4];
    const float* lq1 = args.in[5]; const float* lk1 = args.in[6]; const float* lq2 = args.in[7]; const float* lk2 = args.in[8]; const float* subln_w = args.in[9];
    const float* conv_w = args.in[10]; const float* w_out = args.in[11]; const float* ffn_norm_w = args.in[12]; const float* w_gate = args.in[13]; const float* w_up = args.in[14]; const float* w_down = args.in[15];
    float* out = args.out;
    bf16* Win_t = (bf16*)(ws + WS_WIN); bf16* Wout_t = (bf16*)(ws + WS_WOUT); bf16* Wgu_t = (bf16*)(ws + WS_WGU); bf16* Wdn_t = (bf16*)(ws + WS_WDN);
    bf16* XN = (bf16*)(ws + WS_XN); bf16* QB_ = (bf16*)(ws + WS_Q); bf16* KB_ = (bf16*)(ws + WS_K); bf16* VB_ = (bf16*)(ws + WS_V);
    bf16* GB_ = (bf16*)(ws + WS_GB); bf16* GC_ = (bf16*)(ws + WS_GC); bf16* HC_ = (bf16*)(ws + WS_HC); bf16* MIX = (bf16*)(ws + WS_MIX); bf16* HB = (bf16*)(ws + WS_H); bf16* H1 = (bf16*)(ws + WS_H1);
    f32x2* ROPE = (f32x2*)(ws + WS_ROPE); float* SS = (float*)(ws + WS_SS); float* RS = (float*)(ws + WS_RS);

    const int lo = args.ph_lo, hi = args.ph_hi;
#define IN(k) (lo <= (k) && (k) < hi)
    volatile LAS unsigned* MISC = (volatile LAS unsigned*)(ldsl + LDS_BYTES - 64);
    XcdBarrier bar; bar.bar = (unsigned*)(ws + WS_BAR); bar.x = 0; bar.st = nullptr;
    if (hi - lo > 1) { if (tid < 2) MISC[tid] = 0u; __syncthreads(); bar = xcd_barrier_post((unsigned*)(ws + WS_BAR), MISC); }
#define SEAM(k) do { if (IN(k) && hi > (k) + 1) xcd_barrier(bar); } while (0)
    if (hi < lo) grid.sync();

    if (IN(0)) {
        LAS float* scr = (LAS float*)(ldsl + wave * 16384);
        constexpr int I_IN = (DMODEL / 64) * (INC / 32), I_OUT = (DMODEL / 64) * (DMODEL / 32), I_G = (DMODEL / 64) * (DFF / 32), I_DN = (DFF / 64) * (DMODEL / 32);
        constexpr int NITEMS = I_IN + I_OUT + 2 * I_G;
        for (int it = gw; it < NITEMS; it += NGW) {
            int r = it;
            if (r < I_IN) { const int nb = INC / 32, kb = r / nb, n0 = 32 * (r % nb); const int seg = n0 >> 10, c = n0 & 1023;
                const int qk = 128 * ((c >> 5) & 1) + 32 * ((c >> 6) & 3);
                const int drow = seg == 0 ? 256 * (c >> 8) + qk : seg == 1 ? 256 * (12 + (c >> 8)) + qk : seg == 2 ? 256 * 4 + c : seg == 3 ? 256 * 16 + c
                               : 256 * (((c >> 7) < 4 ? 8 : 16) + (c >> 7)) + (c & 127) + (seg == 5 ? 128 : 0);
                p0_transpose_tile(w_in, INC, 64 * kb, n0, Win_t, DMODEL, drow, scr, lane, attn_norm_w); continue; }     r -= I_IN;
            if (r < I_OUT) { const int nb = DMODEL / 32, kb = r / nb, n0 = 32 * (r % nb); p0_transpose_tile(w_out, DMODEL, 64 * kb, n0, Wout_t, DMODEL, n0, scr, lane); continue; } r -= I_OUT;
            if (r < 2 * I_G) { const bool up = r >= I_G; if (up) r -= I_G; const int nb = DFF / 32, kb = r / nb, n0 = 32 * (r % nb);
                p0_transpose_tile(up ? w_up : w_gate, DFF, 64 * kb, n0, Wgu_t, DMODEL, (n0 >> 7) * 256 + (n0 & 127) + (up ? 128 : 0), scr, lane, ffn_norm_w); continue; }
        }
        for (int e = vcu * (NWAVES * 64) + tid; e < SEQ * 32; e += G * NWAVES * 64) {
            const int pos = e >> 5, i = e & 31; double inv = 1.0; for (int k = 0; k < i; ++k) inv *= 0.7498942093324558;
            const float ang = (float)pos * (float)inv; double rev = (double)ang * 0.15915494309189535; rev -= __builtin_floor(rev);
            const float fr = (float)rev; ROPE[e] = (f32x2){__builtin_amdgcn_cosf(fr), __builtin_amdgcn_sinf(fr)}; }
        for (int m = gw; m < M; m += NGW) x_row_to_bf16(x + (size_t)m * DMODEL, XN + (size_t)m * DMODEL, RS + m, lane);
    }
    SEAM(0);
    if (IN(1)) {
        pg8::Gemm g{XN, Win_t, M, INC, DMODEL}; pg8::StaticOrder S; S.init(M, INC, G, bx);
        LAS float* rxt = (LAS float*)(ldsl + RING_BYTES);
        { pg8::Unit uu; for (int i = (tid >> 8); i < 4; i += 2) if (S.next(i, uu)) rxt[256 * i + (tid & 255)] = RS[uu.pm * 256 + (tid & 255)];
          if (S.next(4, uu)) __builtin_trap();
          __syncthreads(); }
        pg8::EpiInProj E{QB_, (size_t)(WS_K - WS_Q) / 2, q_norm_w, k_norm_w, (const float*)ROPE, attn_body::C2, SEQ - 1, rxt};
        pg8::gemm_phase<pg8::EpiInProj, pg8::StaticOrder, PG8_ALIGN, PG8_SP2>(ldsl, g, S, E);
    }
    SEAM(1);
    if (IN(3)) {
        const float s1 = wave_sum(lq1[lane] * lk1[lane]), s2 = wave_sum(lq2[lane] * lk2[lane]);
        const float lam = __builtin_amdgcn_exp2f(s1 * 1.4426950408889634f) - __builtin_amdgcn_exp2f(s2 * 1.4426950408889634f) + LAM_INIT;
        float mq = __builtin_fabsf(q_norm_w[lane]), mk = __builtin_fabsf(k_norm_w[lane]);
#pragma unroll
        for (int o_ = 1; o_ < 64; o_ <<= 1) { mq = __builtin_fmaxf(mq, __shfl_xor(mq, o_)); mk = __builtin_fmaxf(mk, __shfl_xor(mk, o_)); }
        const float sbound = 64.0f * 1.02f * attn_body::C2 * mq * mk, shv = sbound > 64.0f ? sbound - 64.0f : 0.0f;
        __syncthreads();
        const attn_body::AttnTensors AT{(const attn_body::bf16*)QB_, (const attn_body::bf16*)KB_, (const attn_body::bf16*)VB_, (attn_body::bf16*)MIX, lam, shv, subln_w, (const attn_body::bf16*)GC_, (const attn_body::bf16*)GB_, conv_w};
        const attn_body::StaticOrder S(G, bx);
        attn_body::attn_phase<attn_body::StaticOrder>((char*)lds, AT, S);
    }
    SEAM(3);
    if (IN(5)) {
        pg8::Gemm g{MIX, Wout_t, M, DMODEL, DMODEL}; pg8::StaticOrder S; S.init(M, DMODEL, G, bx);
        pg8::EpiResStats E{XN, DMODEL, H1, SS};
        pg8::gemm_phase<pg8::EpiResStats, pg8::StaticOrder, PG8_ALIGN, PG8_SP2>(ldsl, g, S, E);
    }
    SEAM(5);
    if (IN(7)) {
        pg8::Gemm g{H1, Wgu_t, M, 2 * DFF, DMODEL}; pg8::StaticOrder S; S.init(M, 2 * DFF, G, bx);
        LAS float* rtab = (LAS float*)(ldsl + RING_BYTES);
        {
            pg8::Unit uu; f32x4 sv[3][8]; bool have[3];
#pragma unroll
            for (int j = 0; j < 3; ++j) { have[j] = S.next(2 * j + (tid >> 8), uu);
                if (have[j]) { const f32x4* sp = (const f32x4*)(SS + (size_t)(uu.pm * 256 + (tid & 255)) * 32);
#pragma unroll
                    for (int q = 0; q < 8; ++q) sv[j][q] = sp[q]; } }
#pragma unroll
            for (int j = 0; j < 3; ++j) if (have[j]) { f32x4 a = sv[j][0];
#pragma unroll
                for (int q = 1; q < 8; ++q) a += sv[j][q];
                rtab[256 * (2 * j + (tid >> 8)) + (tid & 255)] = 1.0f / sqrtf(((a[0] + a[1]) + (a[2] + a[3])) * (1.0f / DMODEL) + RMS_EPS); }
            pg8::Unit u6; if (S.next(6, u6)) __builtin_trap();
            __syncthreads();
        }
        pg8::EpiSwiGLU E{HB, DFF, rtab};
        pg8::gemm_phase<pg8::EpiSwiGLU, pg8::StaticOrder, PG8_ALIGN, PG8_SP2>(ldsl, g, S, E);
        {
            constexpr int I_DN = (DFF / 64) * (DMODEL / 32); const int nwg7 = (M / 256) * (2 * DFF / 256), rounds = (nwg7 + G - 1) / G, nidle = rounds * G - nwg7;
            const int hidx = nidle ? bx - (G - nidle) : bx, nh = nidle ? nidle : G; LAS float* scr = (LAS float*)(ldsl + wave * 16384);
            if (hidx >= 0) for (int r = hidx * NWAVES + wave; r < I_DN; r += nh * NWAVES) { const int nb = DMODEL / 32, kb = r / nb, n0 = 32 * (r % nb); p0_transpose_tile(w_down, DMODEL, 64 * kb, n0, Wdn_t, DFF, n0, scr, lane); }
        }
    }
    SEAM(7);
    if (IN(8)) {
        pg8::Gemm g{HB, Wdn_t, M, DMODEL, DFF}; pg8::StaticOrder S; S.init(M, DMODEL, G, bx);
        pg8::EpiResOut E{H1, out, DMODEL};
        pg8::gemm_phase<pg8::EpiResOut, pg8::StaticOrder, PG8_ALIGN, PG8_SP2>(ldsl, g, S, E);
    }
#undef IN
#undef SEAM
}

extern "C" void kernel_launch(void* const* d_in, const int* in_sizes, int n_in, void* d_out, int out_size, void* d_ws, size_t ws_size, hipStream_t stream) {
    static int grid = 0;
    if (grid == 0) {
        if (n_in != 16 || in_sizes[0] != M * DMODEL || out_size != M * DMODEL || ws_size < WS_END) { fprintf(stderr, "kernel_launch: unexpected shapes (n_in %d, in0 %d, out %d, ws %zu); nothing launched\n", n_in, n_in > 0 ? in_sizes[0] : -1, out_size, ws_size); grid = -1; return; }
        int dev = 0, cus = 0, per_cu = 0;
        if (hipGetDevice(&dev) != hipSuccess || hipDeviceGetAttribute(&cus, hipDeviceAttributeMultiprocessorCount, dev) != hipSuccess) { fprintf(stderr, "kernel_launch: device query failed\n"); grid = -1; return; }
        if (hipFuncSetAttribute((const void*)block_fwd, hipFuncAttributeMaxDynamicSharedMemorySize, LDS_BYTES) != hipSuccess) { fprintf(stderr, "kernel_launch: hipFuncSetAttribute failed\n"); grid = -1; return; }
        if (hipOccupancyMaxActiveBlocksPerMultiprocessor(&per_cu, (const void*)block_fwd, NWAVES * 64, LDS_BYTES) != hipSuccess || per_cu < 1) { fprintf(stderr, "kernel_launch: occupancy query says %d\n", per_cu); per_cu = 1; }
        (void)hipGetLastError();
        grid = cus * per_cu;
    }
    if (grid < 0) return;
    if (N_LAUNCHES == 1 && hipMemsetAsync((char*)d_ws + WS_BAR, 0, BAR_BYTES, stream) != hipSuccess) { fprintf(stderr, "kernel_launch: hipMemsetAsync of the barrier words failed\n"); return; }
    Args a{};
    for (int i = 0; i < 16; ++i) a.in[i] = (const float*)d_in[i];
    a.out = (float*)d_out; a.ws = (unsigned char*)d_ws;
    if (N_LAUNCHES == 1) {
        a.ph_lo = 0; a.ph_hi = N_PHASES; void* kargs[] = {&a};
        const hipError_t e = hipLaunchCooperativeKernel((const void*)block_fwd, dim3(grid), dim3(NWAVES * 64), kargs, LDS_BYTES, stream);
        if (e != hipSuccess) fprintf(stderr, "kernel_launch: cooperative launch failed: %s (grid %d)\n", hipGetErrorString(e), grid);
    } else {
        for (int p = 0; p < N_PHASES; ++p) { a.ph_lo = p; a.ph_hi = p + 1; hipLaunchKernelGGL(block_fwd, dim3(grid), dim3(NWAVES * 64), LDS_BYTES, stream, a); }
    }
}
```

```cpp
#include <hip/hip_runtime.h>
#include <cstdio>
#include <cstdint>
namespace pg8 {
#define PG8_LAS __attribute__((address_space(3)))
typedef unsigned short bf16_t;
typedef short bf16x8 __attribute__((ext_vector_type(8)));
typedef float f32x4 __attribute__((ext_vector_type(4)));
typedef unsigned u32x4 __attribute__((ext_vector_type(4)));
constexpr int BM = 256, BK = 64, HALF = 128, HTB = HALF * BK * 2  , STAGE_BYTES = 8 * HTB, NXCD = 8, WGM = 8;

__host__ __device__ __forceinline__ int lds_byte(int r, int c) { const int st = (r >> 4) * 2 + (c >> 5), rr = r & 15, cc = c & 31, ob = rr * 64 + cc * 2; return st * 1024 + (ob ^ (((ob >> 9) & 1) << 5)); }
__host__ __device__ __forceinline__ void stage_rc(int b, int& R, int& C) { const int st = b / 1024, sb = b % 1024, swz = sb ^ (((sb >> 9) & 1) << 5); R = (st >> 1) * 16 + swz / 64; C = (st & 1) * 32 + (swz % 64) / 2; }
__host__ __device__ __forceinline__ int perm32(int rho) { const int n = rho >> 4, i = rho & 15; return 8 * (i >> 2) + 4 * n + (i & 3); }

struct Unit { int pm, pn, idx; };
struct Gemm { const bf16_t* A; const bf16_t* Bt; int M, N, K; };

struct StaticOrder {
    int nM, nN, nwg, G, c;
    __host__ __device__ void init(int M, int N, int G_, int c_) { nM = M / BM; nN = N / BM; nwg = nM * nN; G = G_; c = c_; }
    __host__ __device__ bool next(int i, Unit& u) const {
        const long L = (long)i * G + c; if (L >= nwg) return false;
        int wgid = (int)L; { const int q = nwg / NXCD, r = nwg % NXCD, xcd = wgid % NXCD, off = wgid / NXCD; wgid = (xcd < r ? xcd * (q + 1) : r * (q + 1) + (xcd - r) * q) + off; }
        const int nig = WGM * nN, gid = wgid / nig, fm = gid * WGM, gsz = (nM - fm) < WGM ? (nM - fm) : WGM;
        u.pm = fm + ((wgid % nig) % gsz); u.pn = (wgid % nig) / gsz; u.idx = i; return true;
    }
    __device__ __forceinline__ void a_ready(const Unit&) const {}
    __device__ __forceinline__ void done(const Unit&) const {}
};

__device__ __forceinline__ unsigned cvt_pk_bf16(float lo, float hi) { unsigned r; asm volatile("v_cvt_pk_bf16_f32 %0, %1, %2" : "=v"(r) : "v"(lo), "v"(hi)); return r; }
typedef float f32x2 __attribute__((ext_vector_type(2)));
__device__ __forceinline__ f32x2 gelu_pk(f32x2 v) {
    const f32x2 av = __builtin_elementwise_abs(v), d = av * 0.2316418882f + 1.0f;
    f32x2 t; t.x = __builtin_amdgcn_rcpf(d.x); t.y = __builtin_amdgcn_rcpf(d.y);
    f32x2 q = t * 0.5307027145f + (-0.7265760135f); q = q * t + 0.7107068705f; q = q * t + (-0.142248368f); q = q * t + 0.127414796f; q = q * t;
    const f32x2 s = (v * v) * (-0.72134752044f);
    f32x2 e; e.x = __builtin_amdgcn_exp2f(s.x); e.y = __builtin_amdgcn_exp2f(s.y);
    const f32x2 m = v * (q * e), r = v - m;
    f32x2 o; o.x = v.x < 0.f ? m.x : r.x; o.y = v.y < 0.f ? m.y : r.y; return o;
}

template <int ACT  > struct EpiBf16 {
    static constexpr bool PERM = true, AFTER_DRAIN = false; static_assert(ACT == 0 || ACT == 1, "EpiBf16: ACT is 0 (none) or 1 (gelu_pk)");
    bf16_t* O; int ldc; const float* bias; int split_cols; size_t split_stride; float scale0;
    __device__ __forceinline__ void operator()(const f32x4 (&acc)[2][2][4][2], const Unit& u, int wr, int wc, int fr, int fq) const {
        const int row0 = u.pm * BM + wr * 64 + fr; int colt = u.pn * BM; bf16_t* base = O;
        float sc = 1.f; if (split_cols) { const int t = colt / split_cols; base += (size_t)t * split_stride; colt -= t * split_cols; if (t == 0) sc = scale0; }
        const int col0 = colt + wc * 32 + 8 * fq, bcol0 = u.pn * BM + wc * 32 + 8 * fq;
        f32x4 bv[2][2];
#pragma unroll
        for (int bj = 0; bj < 2; ++bj)
#pragma unroll
            for (int n = 0; n < 2; ++n) bv[bj][n] = bias ? *(const f32x4*)(bias + bcol0 + bj * HALF + 4 * n) : (f32x4){0.f, 0.f, 0.f, 0.f};
#pragma unroll
        for (int ai = 0; ai < 2; ++ai)
#pragma unroll
            for (int m = 0; m < 4; ++m) { bf16_t* rowp = base + (size_t)(row0 + ai * HALF + m * 16) * ldc + col0;
#pragma unroll
                for (int bj = 0; bj < 2; ++bj) { f32x4 v0 = acc[ai][bj][m][0] + bv[bj][0], v1 = acc[ai][bj][m][1] + bv[bj][1];
                    if (ACT == 1) { f32x2 a = gelu_pk((f32x2){v0[0], v0[1]}), b = gelu_pk((f32x2){v0[2], v0[3]}), c = gelu_pk((f32x2){v1[0], v1[1]}), d = gelu_pk((f32x2){v1[2], v1[3]});
                        v0 = (f32x4){a.x, a.y, b.x, b.y}; v1 = (f32x4){c.x, c.y, d.x, d.y}; }
                    v0 = v0 * sc; v1 = v1 * sc; u32x4 w; w.x = cvt_pk_bf16(v0[0], v0[1]); w.y = cvt_pk_bf16(v0[2], v0[3]); w.z = cvt_pk_bf16(v1[0], v1[1]); w.w = cvt_pk_bf16(v1[2], v1[3]);
                    *(u32x4*)(rowp + bj * HALF) = w; } }
    }
};
struct EpiSwiGLU {
    static constexpr bool PERM = true, AFTER_DRAIN = false;
    bf16_t* H; int ldh; const PG8_LAS float* rtab  ;
    static __device__ __forceinline__ float silu_mul(float g, float u) { return g * __builtin_amdgcn_rcpf(1.0f + __builtin_amdgcn_exp2f(-1.4426950408889634f * g)) * u; }
    __device__ __forceinline__ void operator()(const f32x4 (&acc)[2][2][4][2], const Unit& u, int wr, int wc, int fr, int fq) const {
        const int row0 = u.pm * BM + wr * 64 + fr, col0 = u.pn * HALF + wc * 32 + 8 * fq;
#pragma unroll
        for (int ai = 0; ai < 2; ++ai)
#pragma unroll
            for (int m = 0; m < 4; ++m) { const int row = row0 + ai * HALF + m * 16; bf16_t* rowp = H + (size_t)row * ldh + col0;
                const float rstd = rtab[256 * u.idx + ai * HALF + wr * 64 + m * 16 + fr];
                const f32x4 g0 = acc[ai][0][m][0] * rstd, g1 = acc[ai][0][m][1] * rstd, u0 = acc[ai][1][m][0] * rstd, u1 = acc[ai][1][m][1] * rstd;
                u32x4 w; w.x = cvt_pk_bf16(silu_mul(g0[0], u0[0]), silu_mul(g0[1], u0[1])); w.y = cvt_pk_bf16(silu_mul(g0[2], u0[2]), silu_mul(g0[3], u0[3]));
                w.z = cvt_pk_bf16(silu_mul(g1[0], u1[0]), silu_mul(g1[1], u1[1])); w.w = cvt_pk_bf16(silu_mul(g1[2], u1[2]), silu_mul(g1[3], u1[3]));
                *(u32x4*)rowp = w; }
    }
};
struct EpiInProj {
    static constexpr bool PERM = true, AFTER_DRAIN = false;
    bf16_t* O; size_t stride; const float* qnw; const float* knw; const float* rope  ; float qscale; int seqmask;
    const PG8_LAS float* rxt  ;
    __device__ __forceinline__ void operator()(const f32x4 (&acc)[2][2][4][2], const Unit& u, int wr, int wc, int fr, int fq) const {
        const int row0 = u.pm * BM + wr * 64 + fr; const int g = u.pn >> 2, sub = u.pn & 3; const PG8_LAS float* rx0 = rxt + 256 * u.idx + wr * 64 + fr;
        if (g == 0 || g == 3) {
            const bool isq = (g == 0); bf16_t* base = O + (isq ? (size_t)0 : stride); const int colt = sub * BM;
            const float* nwp = (isq ? qnw : knw) + 8 * fq; const float sc = isq ? qscale : 1.0f;
            f32x4 w1[2], w2[2];
#pragma unroll
            for (int n = 0; n < 2; ++n) { w1[n] = *(const f32x4*)(nwp + 4 * n) * sc; w2[n] = *(const f32x4*)(nwp + 32 + 4 * n) * sc; }
#pragma unroll
            for (int am = 0; am < 4; ++am) { const int ai = am >> 1;
                f32x4 c01[4][4];
#pragma unroll
                for (int m = 2 * (am & 1); m < 2 * (am & 1) + 2; ++m) { const float* cs = rope + ((size_t)((row0 + ai * HALF + m * 16) & seqmask) * 32 + 8 * fq) * 2;
#pragma unroll
                    for (int q = 0; q < 4; ++q) c01[m][q] = *(const f32x4*)(cs + 4 * q); }
#pragma unroll
                for (int m = 2 * (am & 1); m < 2 * (am & 1) + 2; ++m) { const int row = row0 + ai * HALF + m * 16;
                    float ss = 0.f;
#pragma unroll
                    for (int n = 0; n < 2; ++n) { const f32x4 a = acc[ai][0][m][n], b = acc[ai][1][m][n]; ss += (a[0] * a[0] + a[1] * a[1]) + (a[2] * a[2] + a[3] * a[3]) + (b[0] * b[0] + b[1] * b[1]) + (b[2] * b[2] + b[3] * b[3]); }
                    ss += __shfl_xor(ss, 16); ss += __shfl_xor(ss, 32);
                    const float rx = rx0[ai * HALF + m * 16];
                    const float rstd = rx / sqrtf(ss * rx * rx * (1.0f / 64.0f) + 1e-6f);
                    float o1[8], o2[8];
#pragma unroll
                    for (int n = 0; n < 2; ++n)
#pragma unroll
                        for (int i = 0; i < 4; ++i) { const float y1 = acc[ai][0][m][n][i] * rstd * w1[n][i], y2 = acc[ai][1][m][n][i] * rstd * w2[n][i];
                            const f32x4 cc = c01[m][2 * n + (i >> 1)]; const float c = cc[2 * (i & 1)], s = cc[2 * (i & 1) + 1];
                            o1[4 * n + i] = y1 * c - y2 * s; o2[4 * n + i] = y2 * c + y1 * s; }
                    bf16_t* rowp = base + (size_t)row * 1024 + colt + 64 * wc + 8 * fq;
                    u32x4 wa, wb; wa.x = cvt_pk_bf16(o1[0], o1[1]); wa.y = cvt_pk_bf16(o1[2], o1[3]); wa.z = cvt_pk_bf16(o1[4], o1[5]); wa.w = cvt_pk_bf16(o1[6], o1[7]);
                    wb.x = cvt_pk_bf16(o2[0], o2[1]); wb.y = cvt_pk_bf16(o2[2], o2[3]); wb.z = cvt_pk_bf16(o2[4], o2[5]); wb.w = cvt_pk_bf16(o2[6], o2[7]);
                    *(u32x4*)rowp = wa; *(u32x4*)(rowp + 32) = wb; } }
        } else if (g == 2 || g == 5) {
            bf16_t* ub = O + 4 * stride; const int col0 = ((g == 5 ? 4 : 0) + sub) * HALF + wc * 32 + 8 * fq;
#pragma unroll
            for (int ai = 0; ai < 2; ++ai)
#pragma unroll
                for (int m = 0; m < 4; ++m) { const float rx = rx0[ai * HALF + m * 16], rx2 = rx * rx; const f32x4 v0 = acc[ai][0][m][0] * acc[ai][1][m][0] * rx2, v1 = acc[ai][0][m][1] * acc[ai][1][m][1] * rx2;
                    u32x4 w; w.x = cvt_pk_bf16(v0[0], v0[1]); w.y = cvt_pk_bf16(v0[2], v0[3]); w.z = cvt_pk_bf16(v1[0], v1[1]); w.w = cvt_pk_bf16(v1[2], v1[3]);
                    *(u32x4*)(ub + (size_t)(row0 + ai * HALF + m * 16) * 1024 + col0) = w; }
        } else {
            bf16_t* base = O + (g == 1 ? 2 : 3) * stride; const int col0 = sub * BM + wc * 32 + 8 * fq;
#pragma unroll
            for (int ai = 0; ai < 2; ++ai)
#pragma unroll
                for (int m = 0; m < 4; ++m) { bf16_t* rowp = base + (size_t)(row0 + ai * HALF + m * 16) * 1024 + col0; const float rx = rx0[ai * HALF + m * 16];
#pragma unroll
                    for (int bj = 0; bj < 2; ++bj) { const f32x4 v0 = acc[ai][bj][m][0] * rx, v1 = acc[ai][bj][m][1] * rx;
                        u32x4 w; w.x = cvt_pk_bf16(v0[0], v0[1]); w.y = cvt_pk_bf16(v0[2], v0[3]); w.z = cvt_pk_bf16(v1[0], v1[1]); w.w = cvt_pk_bf16(v1[2], v1[3]);
                        *(u32x4*)(rowp + bj * HALF) = w; } }
        }
    }
};
struct EpiResStats {
    static constexpr bool PERM = false, AFTER_DRAIN = false;
    const bf16_t* base  ; int ldc; bf16_t* ob; float* ss;
    __device__ __forceinline__ void operator()(const f32x4 (&acc)[2][2][4][2], const Unit& u, int wr, int wc, int fr, int fq) const {
        typedef unsigned u32x2v __attribute__((ext_vector_type(2)));
        const int col0 = u.pn * BM + wc * 32 + 4 * fq;
#pragma unroll
        for (int ai = 0; ai < 2; ++ai)
#pragma unroll
            for (int m = 0; m < 4; ++m) { const size_t off = (size_t)(u.pm * BM + ai * HALF + wr * 64 + m * 16 + fr) * ldc + col0;
                u32x2v bs[2][2];
#pragma unroll
                for (int bj = 0; bj < 2; ++bj)
#pragma unroll
                    for (int n = 0; n < 2; ++n) bs[bj][n] = *(const u32x2v*)(base + off + bj * HALF + n * 16);
                float s = 0.f;
#pragma unroll
                for (int bj = 0; bj < 2; ++bj)
#pragma unroll
                    for (int n = 0; n < 2; ++n) { const u32x2v b = bs[bj][n]; const f32x4 o = (f32x4){__builtin_bit_cast(float, b.x << 16), __builtin_bit_cast(float, b.x & 0xffff0000u), __builtin_bit_cast(float, b.y << 16), __builtin_bit_cast(float, b.y & 0xffff0000u)} + acc[ai][bj][m][n]; s += (o[0] * o[0] + o[1] * o[1]) + (o[2] * o[2] + o[3] * o[3]);
                        u32x2v w; w.x = cvt_pk_bf16(o[0], o[1]); w.y = cvt_pk_bf16(o[2], o[3]); *(u32x2v*)(ob + off + bj * HALF + n * 16) = w; }
                s += __shfl_xor(s, 16); s += __shfl_xor(s, 32);
                if (fq == 0) ss[(size_t)(u.pm * BM + ai * HALF + wr * 64 + m * 16 + fr) * 32 + 4 * u.pn + wc] = s; }
    }
};
struct EpiResOut {
    static constexpr bool PERM = false, AFTER_DRAIN = false;
    const bf16_t* hb; float* out; int ldc;
    __device__ __forceinline__ void operator()(const f32x4 (&acc)[2][2][4][2], const Unit& u, int wr, int wc, int fr, int fq) const {
        typedef unsigned u32x2v __attribute__((ext_vector_type(2)));
        const int col0 = u.pn * BM + wc * 32 + 4 * fq;
#pragma unroll
        for (int ai = 0; ai < 2; ++ai)
#pragma unroll
            for (int m = 0; m < 4; ++m) { const size_t off = (size_t)(u.pm * BM + ai * HALF + wr * 64 + m * 16 + fr) * ldc + col0;
                u32x2v bs[2][2];
#pragma unroll
                for (int bj = 0; bj < 2; ++bj)
#pragma unroll
                    for (int n = 0; n < 2; ++n) bs[bj][n] = *(const u32x2v*)(hb + off + bj * HALF + n * 16);
#pragma unroll
                for (int bj = 0; bj < 2; ++bj)
#pragma unroll
                    for (int n = 0; n < 2; ++n) { const u32x2v b = bs[bj][n];
                        const f32x4 r = (f32x4){__builtin_bit_cast(float, b.x << 16), __builtin_bit_cast(float, b.x & 0xffff0000u), __builtin_bit_cast(float, b.y << 16), __builtin_bit_cast(float, b.y & 0xffff0000u)};
                        __builtin_nontemporal_store(r + acc[ai][bj][m][n], (f32x4*)(out + off + bj * HALF + n * 16)); } }
    }
};

template <class Epi, class Sched, bool ALIGN_EPI = false, bool SP2 = false>
__device__ __forceinline__ void gemm_phase(PG8_LAS unsigned char* lds, const Gemm g, const Sched& S, const Epi& E) {
    const int tid = threadIdx.x, wid = __builtin_amdgcn_readfirstlane(tid >> 6), lane = tid & 63, wr = wid >> 2, wc = wid & 3, fr = lane & 15, fq = lane >> 4;
    const int K = g.K, nt = K / BK;
    unsigned voffA[2], voffB[2];
#pragma unroll
    for (int i = 0; i < 2; ++i) { int R, C; stage_rc(tid * 16 + i * 8192, R, C); const int Rb = Epi::PERM ? ((R & ~31) + perm32(R & 31)) : R;
        voffA[i] = (unsigned)(R * K + C) * 2u; voffB[i] = (unsigned)(Rb * K + C) * 2u; }
    const size_t kstep = (size_t)(BK * 2);
    const size_t hstep = (size_t)HALF * K * 2;
    const size_t tstep = 2 * hstep;
    const unsigned ldsw = (unsigned)wid * 1024u;
    const int aoff = lds_byte(wr * 64 + fr, fq * 8), boff = lds_byte(wc * 32 + fr, fq * 8);
#define PG8_SA(b, h) (((b) * 2 + (h)) * HTB)
#define PG8_SB(b, h) ((4 + (b) * 2 + (h)) * HTB)
#define PG8_STAGE(bufoff, gbase, voff) do { _Pragma("unroll") for (int _i = 0; _i < 2; ++_i) \
        __builtin_amdgcn_global_load_lds((const unsigned*)((const char*)(gbase) + (voff)[_i]), (PG8_LAS unsigned*)(lds + (bufoff) + ldsw + _i * 8192), 16, 0, 0); } while (0)
#define PG8_LDA(dst, b, h) do { _Pragma("unroll") for (int m = 0; m < 4; ++m) _Pragma("unroll") for (int k = 0; k < 2; ++k) dst[m][k] = *(const PG8_LAS bf16x8*)(lds + PG8_SA(b, h) + aoff + m * 2048 + k * 1024); } while (0)
#define PG8_LDB(dst, b, h) do { _Pragma("unroll") for (int n = 0; n < 2; ++n) _Pragma("unroll") for (int k = 0; k < 2; ++k) dst[n][k] = *(const PG8_LAS bf16x8*)(lds + PG8_SB(b, h) + boff + n * 2048 + k * 1024); } while (0)
#define PG8_MMA(ai, bj, At, Bt) do { __builtin_amdgcn_s_setprio(1); _Pragma("unroll") for (int m = 0; m < 4; ++m) _Pragma("unroll") for (int n = 0; n < 2; ++n) _Pragma("unroll") for (int k = 0; k < 2; ++k) \
        acc[ai][bj][m][n] = __builtin_amdgcn_mfma_f32_16x16x32_bf16(Bt[n][k], At[m][k], acc[ai][bj][m][n], 0, 0, 0); __builtin_amdgcn_s_setprio(0); } while (0)
#define PG8_WAIT_V(n) asm volatile("s_waitcnt vmcnt(" #n ")" ::: "memory")
#define PG8_WAIT_L(n) asm volatile("s_waitcnt lgkmcnt(" #n ")" ::: "memory")
#define PG8_BAR __builtin_amdgcn_s_barrier()
#define PG8_SCHED __builtin_amdgcn_sched_barrier(0)
    Unit cur, nxt; int ui = 0;
    if (!S.next(0, cur)) return;
    f32x4 acc[2][2][4][2];
#pragma unroll
    for (int a = 0; a < 2; ++a)
#pragma unroll
        for (int b = 0; b < 2; ++b)
#pragma unroll
            for (int m = 0; m < 4; ++m)
#pragma unroll
                for (int n = 0; n < 2; ++n) acc[a][b][m][n] = (f32x4){0.f, 0.f, 0.f, 0.f};
    bf16x8 At[4][2], B0[2][2], B1[2][2];
    const char* cA = (const char*)g.A + (size_t)cur.pm * tstep; const char* cB = (const char*)g.Bt + (size_t)cur.pn * tstep;
    S.a_ready(cur);
    if constexpr (SP2) {
        PG8_STAGE(PG8_SB(0, 0), cB, voffB); PG8_STAGE(PG8_SB(0, 1), cB + hstep, voffB); PG8_STAGE(PG8_SA(0, 0), cA, voffA); PG8_STAGE(PG8_SA(0, 1), cA + hstep, voffA);
        if (wr == 1) PG8_BAR;
        PG8_WAIT_V(2); PG8_BAR;
        PG8_STAGE(PG8_SB(1, 0), cB + kstep, voffB); PG8_STAGE(PG8_SA(1, 0), cA + kstep, voffA); PG8_STAGE(PG8_SB(1, 1), cB + hstep + kstep, voffB);
        PG8_WAIT_V(6); PG8_BAR;
    } else {
        PG8_STAGE(PG8_SB(0, 0), cB, voffB); PG8_STAGE(PG8_SA(0, 0), cA, voffA); PG8_STAGE(PG8_SB(0, 1), cB + hstep, voffB); PG8_STAGE(PG8_SA(0, 1), cA + hstep, voffA);
        if (wr == 1) PG8_BAR;
        PG8_WAIT_V(4); PG8_BAR;
        PG8_STAGE(PG8_SB(1, 0), cB + kstep, voffB); PG8_STAGE(PG8_SA(1, 0), cA + kstep, voffA); PG8_STAGE(PG8_SB(1, 1), cB + hstep + kstep, voffB);
        PG8_WAIT_V(6); PG8_BAR;
    }
    for (;;) {
        const bool has_next = S.next(ui + 1, nxt);
        const char* nA = has_next ? (const char*)g.A + (size_t)nxt.pm * tstep : cA; const char* nB = has_next ? (const char*)g.Bt + (size_t)nxt.pn * tstep : cB;
        for (int t = 0; t < nt; t += 2) {
            const bool last = (t == nt - 2);
            const char* a1 = cA + (size_t)(t + 1) * kstep;
            const char* a2 = last ? nA : cA + (size_t)(t + 2) * kstep; const char* b2 = last ? nB : cB + (size_t)(t + 2) * kstep;
            const char* a3 = a2 + kstep; const char* b3 = b2 + kstep;
            if (last && has_next) S.a_ready(nxt);
            if constexpr (SP2) {
            PG8_LDB(B0, 0, 0); PG8_LDB(B1, 0, 1); PG8_SCHED; PG8_LDA(At, 0, 0); PG8_STAGE(PG8_SA(1, 1), a1 + hstep, voffA);
            PG8_WAIT_V(8); PG8_WAIT_L(0); PG8_BAR; PG8_MMA(0, 0, At, B0); PG8_MMA(0, 1, At, B1); PG8_BAR; PG8_SCHED;
            PG8_LDA(At, 0, 1); PG8_STAGE(PG8_SB(0, 0), b2, voffB); PG8_STAGE(PG8_SB(0, 1), b2 + hstep, voffB); PG8_STAGE(PG8_SA(0, 0), a2, voffA);
            PG8_WAIT_V(8); PG8_WAIT_L(0); PG8_BAR; PG8_MMA(1, 0, At, B0); PG8_MMA(1, 1, At, B1); PG8_BAR; PG8_SCHED;
            PG8_LDB(B0, 1, 0); PG8_LDB(B1, 1, 1); PG8_SCHED; PG8_LDA(At, 1, 0); PG8_STAGE(PG8_SA(0, 1), a2 + hstep, voffA);
            PG8_WAIT_V(8); PG8_WAIT_L(0); PG8_BAR; PG8_MMA(0, 0, At, B0); PG8_MMA(0, 1, At, B1); PG8_BAR; PG8_SCHED;
            PG8_LDA(At, 1, 1); PG8_STAGE(PG8_SB(1, 0), b3, voffB); PG8_STAGE(PG8_SB(1, 1), b3 + hstep, voffB); PG8_STAGE(PG8_SA(1, 0), a3, voffA);
            PG8_WAIT_V(8); PG8_WAIT_L(0); PG8_BAR; PG8_MMA(1, 0, At, B0); PG8_MMA(1, 1, At, B1); PG8_BAR; PG8_SCHED;
            } else {
            PG8_LDB(B0, 0, 0); PG8_SCHED; PG8_LDA(At, 0, 0); PG8_STAGE(PG8_SA(1, 1), a1 + hstep, voffA);
            PG8_WAIT_L(8); PG8_BAR; PG8_WAIT_L(0); PG8_MMA(0, 0, At, B0); PG8_BAR; PG8_SCHED;
            PG8_LDB(B1, 0, 1); PG8_STAGE(PG8_SB(0, 0), b2, voffB);
            PG8_BAR; PG8_WAIT_L(0); PG8_MMA(0, 1, At, B1); PG8_BAR;
            PG8_LDA(At, 0, 1); PG8_STAGE(PG8_SA(0, 0), a2, voffA);
            PG8_BAR; PG8_WAIT_L(0); PG8_MMA(1, 0, At, B0); PG8_BAR; PG8_SCHED;
            PG8_STAGE(PG8_SB(0, 1), b2 + hstep, voffB);
            PG8_WAIT_V(6); PG8_BAR; PG8_MMA(1, 1, At, B1); PG8_BAR;
            PG8_LDB(B0, 1, 0); PG8_SCHED; PG8_LDA(At, 1, 0); PG8_STAGE(PG8_SA(0, 1), a2 + hstep, voffA);
            PG8_WAIT_L(8); PG8_BAR; PG8_WAIT_L(0); PG8_MMA(0, 0, At, B0); PG8_BAR; PG8_SCHED;
            PG8_LDB(B1, 1, 1); PG8_STAGE(PG8_SB(1, 0), b3, voffB);
            PG8_BAR; PG8_WAIT_L(0); PG8_MMA(0, 1, At, B1); PG8_BAR;
            PG8_LDA(At, 1, 1); PG8_STAGE(PG8_SA(1, 0), a3, voffA);
            PG8_BAR; PG8_WAIT_L(0); PG8_MMA(1, 0, At, B0); PG8_BAR; PG8_SCHED;
            PG8_STAGE(PG8_SB(1, 1), b3 + hstep, voffB);
            PG8_WAIT_V(6); PG8_BAR; PG8_MMA(1, 1, At, B1); PG8_BAR;
            }
        }
        if constexpr (ALIGN_EPI) { if (wr == 0) PG8_BAR; }
        if constexpr (!Epi::AFTER_DRAIN) { E(acc, cur, wr, wc, fr, fq); S.done(cur); }
        if (!has_next) break;
#pragma unroll
        for (int a = 0; a < 2; ++a)
#pragma unroll
            for (int b = 0; b < 2; ++b)
#pragma unroll
                for (int m = 0; m < 4; ++m)
#pragma unroll
                    for (int n = 0; n < 2; ++n) acc[a][b][m][n] = (f32x4){0.f, 0.f, 0.f, 0.f};
        cur = nxt; cA = nA; cB = nB; ++ui;
        if constexpr (ALIGN_EPI) { if (wr == 1) PG8_BAR; }
    }
    PG8_WAIT_V(0);
    if constexpr (!ALIGN_EPI) { if (wr == 0) PG8_BAR; }
    PG8_BAR;
    if constexpr (Epi::AFTER_DRAIN) { E.fused(acc, cur, wr, wc, fr, fq, lds, wid, lane); S.done(cur); }
#undef PG8_SA
#undef PG8_SB
#undef PG8_STAGE
#undef PG8_LDA
#undef PG8_LDB
#undef PG8_MMA
#undef PG8_WAIT_V
#undef PG8_WAIT_L
#undef PG8_BAR
#undef PG8_SCHED
}
}

#ifndef PG8_SP2
#define PG8_SP2 true
#endif
#ifndef PG8_ALIGN
#define PG8_ALIGN true
#endif
#include <hip/hip_bf16.h>
#include <cmath>
namespace attn_body {
using bf16=__hip_bfloat16;
using bf16x8=__attribute__((ext_vector_type(8)))short;
using s16x4=__attribute__((ext_vector_type(4)))short;
using f32x16=__attribute__((ext_vector_type(16)))float;
using u32x4=__attribute__((ext_vector_type(4)))unsigned;
constexpr int SEQ=4096,D=64,DM=1024,OPITCH=2048;
constexpr int NW=8,QBLK=32,QB=128,KVBLK=64,NQB=SEQ/QB;
constexpr int ATTN_PITCH=DM, ATTN_UNIT_ROWS=QB;
__device__ __forceinline__ int crow(int r,int hi){return (r&3)+8*(r>>2)+4*hi;}
#define SBAR() __builtin_amdgcn_sched_barrier(0)
__device__ __forceinline__ void cmask(f32x16&p0,f32x16&p1,int jb,int qrel,int hi){
  const float NEG=-INFINITY; (void)hi;
  if(jb>(qrel>>6)){
  #pragma unroll
  for(int r=0;r<16;++r){p0[r]=NEG;p1[r]=NEG;} }
}

constexpr int NSLOT=3, KSLOT=4, SLOTB=8192;
constexpr int LDS_K=0, LDS_V=2*KSLOT*SLOTB, LDS_WS=LDS_V+2*NSLOT*SLOTB, LDS_OST=0  , LDS_BYTES=LDS_WS+NW*64*4;
constexpr float C2=0.125f*1.4426950408889634f;
__device__ __forceinline__ void glds16(const void*gsrc,unsigned lds_dst){unsigned keep;
  asm volatile("s_mov_b32 %0, m0\n\ts_mov_b32 m0, %2\n\ts_nop 0\n\tglobal_load_lds_dwordx4 %1, off\n\ts_mov_b32 m0, %0":"=&s"(keep):"v"(gsrc),"s"(lds_dst):"memory");}
__device__ __forceinline__ void glds16s(const void*sbase,unsigned voff,unsigned lds_dst){unsigned keep;
  asm volatile("s_mov_b32 %0, m0\n\ts_mov_b32 m0, %3\n\ts_nop 0\n\tglobal_load_lds_dwordx4 %1, %2\n\ts_mov_b32 m0, %0":"=&s"(keep):"v"(voff),"s"(sbase),"s"(lds_dst):"memory");}
__device__ __forceinline__ float max3f(float a,float b,float c){float r;asm("v_max3_f32 %0, %1, %2, %3":"=v"(r):"v"(a),"v"(b),"v"(c));return r;}
__device__ __forceinline__ float max2f(float a,float b){float r;asm("v_max_f32_e32 %0, %1, %2":"=v"(r):"v"(a),"v"(b));return r;}
__device__ __forceinline__ float fadd_s(float a,float b){float r;asm("v_add_f32_e32 %0, %1, %2":"=v"(r):"v"(a),"v"(b));return r;}
__device__ __forceinline__ float fsub_s(float a,float b){float r;asm("v_sub_f32_e32 %0, %1, %2":"=v"(r):"v"(a),"v"(b));return r;}
typedef float f32x2_t __attribute__((ext_vector_type(2))); typedef __bf16 bf16x2_t __attribute__((ext_vector_type(2)));
__device__ __forceinline__ unsigned cvtpk_s(float lo,float hi){f32x2_t v={lo,hi};bf16x2_t b=__builtin_convertvector(v,bf16x2_t);return __builtin_bit_cast(unsigned,b);}
#define WAIT_BAR(N) asm volatile("s_waitcnt vmcnt(" #N ") lgkmcnt(0)\n\ts_barrier":::"memory")

__device__ __forceinline__ void qkt(f32x16&p0,f32x16&p1,const char*Kslot,const bf16x8*qr,const f32x16&negm,int r32,int hi){
  const char*kb=Kslot+hi*1024+r32*16;
  #pragma unroll
  for(int d0=0;d0<4;++d0){
    const bf16x8 b0=*reinterpret_cast<const bf16x8*>(kb+d0*2048);
    const bf16x8 b1=*reinterpret_cast<const bf16x8*>(kb+d0*2048+512);
    if(d0==0){p0=__builtin_amdgcn_mfma_f32_32x32x16_bf16(b0,qr[0],negm,0,0,0);p1=__builtin_amdgcn_mfma_f32_32x32x16_bf16(b1,qr[0],negm,0,0,0);}
    else{p0=__builtin_amdgcn_mfma_f32_32x32x16_bf16(b0,qr[d0],p0,0,0,0);p1=__builtin_amdgcn_mfma_f32_32x32x16_bf16(b1,qr[d0],p1,0,0,0);}}
}
typedef __attribute__((address_space(3))) const char* lds_cptr;
typedef short v4i16_t __attribute__((ext_vector_type(4)));
__device__ __forceinline__ void kload8(bf16x8*kf,lds_cptr kp){
  kf[0]=*(const __attribute__((address_space(3))) bf16x8*)(kp);      kf[1]=*(const __attribute__((address_space(3))) bf16x8*)(kp+512);
  kf[2]=*(const __attribute__((address_space(3))) bf16x8*)(kp+2048); kf[3]=*(const __attribute__((address_space(3))) bf16x8*)(kp+2560);
  kf[4]=*(const __attribute__((address_space(3))) bf16x8*)(kp+4096); kf[5]=*(const __attribute__((address_space(3))) bf16x8*)(kp+4608);
  kf[6]=*(const __attribute__((address_space(3))) bf16x8*)(kp+6144); kf[7]=*(const __attribute__((address_space(3))) bf16x8*)(kp+6656);
}
__device__ __forceinline__ void kload2(bf16x8*kf,lds_cptr kp,int j){ kf[2*j]=*(const __attribute__((address_space(3))) bf16x8*)(kp+j*2048); kf[2*j+1]=*(const __attribute__((address_space(3))) bf16x8*)(kp+j*2048+512); }
__device__ __forceinline__ s16x4 vtr(lds_cptr p){ return __builtin_bit_cast(s16x4,__builtin_amdgcn_ds_read_tr16_b64_v4i16((__attribute__((address_space(3))) v4i16_t*)p)); }
__device__ __forceinline__ float rowmax(const f32x16&p0,const f32x16&p1){
  float a=max3f(p0[0],p0[1],p1[0]),b=max3f(p0[2],p0[3],p1[1]);a=max3f(a,p1[2],p1[3]);
  #pragma unroll
  for(int r=4;r<16;r+=4){a=max3f(a,p0[r],p0[r+1]);b=max3f(b,p0[r+2],p0[r+3]);a=max3f(a,p1[r],p1[r+1]);b=max3f(b,p1[r+2],p1[r+3]);}
  const float m=max2f(a,b);
  auto rr=__builtin_amdgcn_permlane32_swap(__float_as_uint(m),__float_as_uint(m),false,false);
  return max2f(__uint_as_float(rr[0]),__uint_as_float(rr[1]));
}
__device__ __forceinline__ void pv(f32x16*o,int vb,bf16x8 pa0,bf16x8 pa1,bf16x8 pa2,bf16x8 pa3){
  #pragma unroll
  for(int d0=0;d0<2;++d0){s16x4 lo[4],hi[4];
    #pragma unroll
    for(int ks=0;ks<4;++ks){
      asm volatile("ds_read_b64_tr_b16 %0,%1 offset:%c2":"=&v"(lo[ks]):"v"(vb),"i"(d0*4096+ks*1024):"memory");
      asm volatile("ds_read_b64_tr_b16 %0,%1 offset:%c2":"=&v"(hi[ks]):"v"(vb),"i"(d0*4096+ks*1024+512):"memory");}
    asm volatile("s_waitcnt lgkmcnt(0)":::"memory");SBAR();
    #define PK(k) (bf16x8){lo[k][0],lo[k][1],lo[k][2],lo[k][3],hi[k][0],hi[k][1],hi[k][2],hi[k][3]}
    o[d0]=__builtin_amdgcn_mfma_f32_32x32x16_bf16(pa0,PK(0),o[d0],0,0,0);
    o[d0]=__builtin_amdgcn_mfma_f32_32x32x16_bf16(pa1,PK(1),o[d0],0,0,0);
    o[d0]=__builtin_amdgcn_mfma_f32_32x32x16_bf16(pa2,PK(2),o[d0],0,0,0);
    o[d0]=__builtin_amdgcn_mfma_f32_32x32x16_bf16(pa3,PK(3),o[d0],0,0,0);
    #undef PK
  }
}

#ifndef ATTN_STORE16
#define ATTN_STORE16(p,v) (*(u32x4*)(p)=(v))
#endif
template<int THRL,bool SHF> __device__ __forceinline__ void attn_unit(int b,int h,int qb,int lin,float sh,const bf16*Q,const bf16*__restrict__ K,const bf16*__restrict__ V,bf16*MIXO,float lam,const float*__restrict__ subw,const bf16*__restrict__ CU,const bf16*__restrict__ CG,const float*__restrict__ convw,char*shm){
  const int tid=threadIdx.x,lane=tid&63,r32=lane&31,hi=lane>>5; const int wid=__builtin_amdgcn_readfirstlane(tid>>6);
  const int c=wid>>2,wq=wid&3;
  const long rowbase=(long)b*SEQ; const int q0=qb*QB;
  const bf16*Qw=Q+(rowbase+q0+wq*QBLK)*DM+h*128+c*64;
  const bf16*Kh=K+rowbase*DM+h*128,*Vh=V+rowbase*DM+h*128;
  const unsigned lds0=(unsigned)(uintptr_t)shm;
  float*wsf=(float*)(shm+LDS_WS)+wid*64;
  const unsigned koffb=(unsigned)(lane*DM+wid*8)*2u;
  const unsigned voffb=(unsigned)((16*(wid&3)+(lane>>2))*DM+(wid>>2)*32+(lane&3)*8)*2u;
  const unsigned kdst=lds0+LDS_K+wid*1024, vdst=lds0+LDS_V+wid*1024;
  #define DMA_K(t,slot) do{ glds16s(Kh+(long)(t)*KVBLK*DM,koffb,(unsigned)__builtin_amdgcn_readfirstlane(kdst+2*(slot))); glds16s(Kh+(long)(t)*KVBLK*DM+64,koffb,(unsigned)__builtin_amdgcn_readfirstlane(kdst+2*(slot)+8192)); }while(0)
  #define DMA_V(t,slot) do{ glds16s(Vh+(long)(t)*KVBLK*DM,voffb,(unsigned)__builtin_amdgcn_readfirstlane(vdst+2*(slot))); glds16s(Vh+(long)(t)*KVBLK*DM+64,voffb,(unsigned)__builtin_amdgcn_readfirstlane(vdst+2*(slot)+8192)); }while(0)
  const int vb0=(int)(lds0+LDS_V)+((lane>>4)&1)*32+(lane&3)*8+(4*hi+((lane&15)>>2))*64;
  const char*Kbase=shm+LDS_K+c*8192; bf16x8 kf[8];
  const lds_cptr shm3=(lds_cptr)shm; const lds_cptr kp0=shm3+LDS_K+c*8192+hi*1024+r32*16; const lds_cptr vp0=shm3+LDS_V+((lane>>4)&1)*32+(lane&3)*8+(4*hi+((lane&15)>>2))*64;
  const int NT=(q0+QB)/KVBLK;
  u32x4 cvu[2][3],cvg[2];
  #define CONV_LOAD(k0) do{ _Pragma("unroll") for(int k=0;k<2;++k){ const int item=lin*32+wid*4+(k0)+k,m=item>>1,col=(item&1)*512+lane*8,tt=m&(SEQ-1); \
    _Pragma("unroll") for(int j=0;j<3;++j){ const int dt=2-j; cvu[k][j]=(tt-dt>=0)?*(const u32x4*)(CU+(long)(m-dt)*1024+col):(u32x4){0u,0u,0u,0u}; } \
    cvg[k]=*(const u32x4*)(CG+(long)m*1024+col); } }while(0)
  #define CONV_FINISH(k0) do{ _Pragma("unroll") for(int k=0;k<2;++k){ const int item=lin*32+wid*4+(k0)+k,m=item>>1,col=(item&1)*512+lane*8; float ca[8]; \
    _Pragma("unroll") for(int i=0;i<8;++i)ca[i]=0.f; \
    _Pragma("unroll") for(int j=0;j<3;++j){ const float*wj=convw+j*1024+col; const unsigned uw[4]={cvu[k][j].x,cvu[k][j].y,cvu[k][j].z,cvu[k][j].w}; \
      _Pragma("unroll") for(int i=0;i<4;++i){ ca[2*i]+=wj[2*i]*__uint_as_float(uw[i]<<16); ca[2*i+1]+=wj[2*i+1]*__uint_as_float(uw[i]&0xffff0000u); } } \
    const unsigned gw_[4]={cvg[k].x,cvg[k].y,cvg[k].z,cvg[k].w}; u32x4 ov; \
    ov.x=cvtpk_s(ca[0]*__uint_as_float(gw_[0]<<16),ca[1]*__uint_as_float(gw_[0]&0xffff0000u)); ov.y=cvtpk_s(ca[2]*__uint_as_float(gw_[1]<<16),ca[3]*__uint_as_float(gw_[1]&0xffff0000u)); \
    ov.z=cvtpk_s(ca[4]*__uint_as_float(gw_[2]<<16),ca[5]*__uint_as_float(gw_[2]&0xffff0000u)); ov.w=cvtpk_s(ca[6]*__uint_as_float(gw_[3]<<16),ca[7]*__uint_as_float(gw_[3]&0xffff0000u)); \
    *(u32x4*)(MIXO+(long)m*OPITCH+1024+col)=ov; } }while(0)
  CONV_LOAD(0);
  DMA_K(0,0);DMA_V(0,0);DMA_K(1,SLOTB);
  bf16x8 qr[4];
  #pragma unroll
  for(int d0=0;d0<4;++d0)qr[d0]=*reinterpret_cast<const bf16x8*>(&Qw[(long)r32*DM+d0*16+hi*8]);
  float l_reg=0.f;f32x16 o[4];o[0]=f32x16{};o[1]=f32x16{};o[2]=f32x16{};o[3]=f32x16{};const f32x16 zero16=f32x16{};
  const int qrel=wq*QBLK+r32;
  #define CMASK(P0,P1,t) do{int jb_=(t)-(NT-2); if(jb_>=0)cmask(P0,P1,jb_,qrel,hi);}while(0)
  f32x16 C0,C1;
  int sl_prev=0,sl_cur=0,sl_next=SLOTB;
  int ks_prev=3*SLOTB,ks_cur=0,ks_next=SLOTB;
  #define ROT() do{sl_prev=sl_cur;sl_cur=sl_next;sl_next=(sl_next==(NSLOT-1)*SLOTB)?0:sl_next+SLOTB; ks_prev=ks_cur;ks_cur=ks_next;ks_next=(ks_next==(KSLOT-1)*SLOTB)?0:ks_next+SLOTB;}while(0)
  DMA_K(2,2*SLOTB);
  WAIT_BAR(6);
  s16x4 vlo[8],vhi[8]; u32x4 pa0,pa1,pa2,pa3,pb0,pb1,pb2,pb3;
  #define PKW(P,B) cvtpk_s(P[B],P[B+1])
  CONV_FINISH(0); CONV_LOAD(2);
  qkt(C0,C1,Kbase,qr,zero16,r32,hi);asm volatile("s_nop 15\n\ts_nop 7":"+v"(C0),"+v"(C1));CMASK(C0,C1,0);
  #define SHX(v) (SHF?(v)-sh:(v))
  _Pragma("unroll") for(int r=0;r<16;++r){C0[r]=__builtin_amdgcn_exp2f(SHX(C0[r]));C1[r]=__builtin_amdgcn_exp2f(SHX(C1[r]));}
  { float sacc=C0[0]+C0[1]; _Pragma("unroll") for(int r=2;r<16;++r)sacc+=C0[r]; _Pragma("unroll") for(int r=0;r<16;++r)sacc+=C1[r]; l_reg+=sacc;
    pa0=(u32x4){PKW(C0,0),PKW(C0,2),PKW(C0,4),PKW(C0,6)};pa1=(u32x4){PKW(C0,8),PKW(C0,10),PKW(C0,12),PKW(C0,14)};pa2=(u32x4){PKW(C1,0),PKW(C1,2),PKW(C1,4),PKW(C1,6)};pa3=(u32x4){PKW(C1,8),PKW(C1,10),PKW(C1,12),PKW(C1,14)}; }
  WAIT_BAR(0);
  CONV_FINISH(2);
  #undef CONV_LOAD
  #undef CONV_FINISH
  DMA_K(3,3*SLOTB);DMA_V(1,SLOTB);
  ROT();
  { const lds_cptr kp_=kp0+2*ks_cur; kf[0]=*(const __attribute__((address_space(3))) bf16x8*)(kp_); kf[2]=*(const __attribute__((address_space(3))) bf16x8*)(kp_+2048); }
  if(NT==2){WAIT_BAR(0);}else{WAIT_BAR(4);}
  #define BC8(x) __builtin_bit_cast(bf16x8,x)
  #define VFR(i) (bf16x8){vlo[i][0],vlo[i][1],vlo[i][2],vlo[i][3],vhi[i][0],vhi[i][1],vhi[i][2],vhi[i][3]}
  #define PIN(x) asm volatile("":"+v"(x))
  #define MX3(a,b,c) __builtin_fmaxf(__builtin_fmaxf((a),(b)),(c))
  #define EX(v) __builtin_amdgcn_exp2f(v)
  #define MF(a,b,c) __builtin_amdgcn_mfma_f32_32x32x16_bf16(a,b,c,0,0,0)
  #define VRDH(i,h) do{ vlo[i]=vtr(vp_+((h)*8192+((i)>>2)*4096+((i)&3)*1024)); vhi[i]=vtr(vp_+((h)*8192+((i)>>2)*4096+((i)&3)*1024+512)); }while(0)
  #define KRD(G,j) do{ if(G){ kload2(kf,kp0+2*ks_next,j); } }while(0)
  #define GAPB(D,MF_,RD_,X,B,PW,e) do{ MF_; PIN(o[D]); RD_; X[B]=EX(SHX(X[B])); X[B+1]=EX(SHX(X[B+1])); sacc+=X[B]; sacc+=X[B+1]; PW[e]=cvtpk_s(X[B],X[B+1]); PIN(X); PIN(sacc); PIN(PW); SBAR(); }while(0)
  #define KLD(i) kf[i]=*(const __attribute__((address_space(3))) bf16x8*)(kp_+((i)>>1)*2048+((i)&1)*512)
  #define KLDN(i) do{ if(gl_){ kf[i]=*(const __attribute__((address_space(3))) bf16x8*)(kn_+((i)>>1)*2048+((i)&1)*512); } }while(0)
  #define PINF(x) asm volatile("":"+v"(x))
  #define STEP(PP0,PP1,PP2,PP3,PN0,PN1,PN2,PN3,t,GK,GV,GL) do{ SBAR(); \
    const lds_cptr vp_=vp0+2*sl_prev; const lds_cptr kp_=kp0+2*ks_cur; const lds_cptr kn_=kp0+2*ks_next; const bool gl_=(GL); float sacc=0.f,ep=0.f; \
    KLD(4); KLD(6); VRDH(0,0); SBAR(); C0=MF(kf[0],qr[0],zero16); SBAR(); \
    KLD(1); KLD(3); VRDH(4,0); SBAR(); C0=MF(kf[2],qr[1],C0); SBAR(); \
    KLD(5); KLD(7); VRDH(1,0); SBAR(); C0=MF(kf[4],qr[2],C0); SBAR(); \
    VRDH(5,0); SBAR(); C0=MF(kf[6],qr[3],C0); PIN(C0); SBAR(); \
    CMASK(C0,C0,t); \
    C1=MF(kf[1],qr[0],zero16); PIN(C1); VRDH(2,0); { float e0=EX(SHX(C0[0])),e1=EX(SHX(C0[1])),e2=EX(SHX(C0[2])),e3=EX(SHX(C0[3])); sacc+=e0; sacc+=e1; sacc+=e2; sacc+=e3; PN0[0]=cvtpk_s(e0,e1); PN0[1]=cvtpk_s(e2,e3); } PIN(sacc); PIN(PN0); SBAR(); \
    C1=MF(kf[3],qr[1],C1); PIN(C1); VRDH(6,0); { float e0=EX(SHX(C0[4])),e1=EX(SHX(C0[5])),e2=EX(SHX(C0[6])),e3=EX(SHX(C0[7])); sacc+=e0; sacc+=e1; sacc+=e2; sacc+=e3; PN0[2]=cvtpk_s(e0,e1); PN0[3]=cvtpk_s(e2,e3); } PIN(sacc); PIN(PN0); SBAR(); \
    C1=MF(kf[5],qr[2],C1); PIN(C1); VRDH(3,0); { float e0=EX(SHX(C0[8])),e1=EX(SHX(C0[9])),e2=EX(SHX(C0[10])),e3=EX(SHX(C0[11])); sacc+=e0; sacc+=e1; sacc+=e2; sacc+=e3; PN1[0]=cvtpk_s(e0,e1); PN1[1]=cvtpk_s(e2,e3); } PIN(sacc); PIN(PN1); SBAR(); \
    C1=MF(kf[7],qr[3],C1); PIN(C1); VRDH(7,0); { float e0=EX(SHX(C0[12])),e1=EX(SHX(C0[13])),e2=EX(SHX(C0[14])),e3=EX(SHX(C0[15])); sacc+=e0; sacc+=e1; sacc+=e2; sacc+=e3; PN1[2]=cvtpk_s(e0,e1); PN1[3]=cvtpk_s(e2,e3); } PIN(sacc); PIN(PN1); SBAR(); \
    if(GK){DMA_K((t)+3,ks_prev);} if(GV){DMA_V((t)+1,sl_next);} \
    CMASK(C1,C1,t); \
    SBAR(); \
    o[0]=MF(BC8(PP0),VFR(0),o[0]); PIN(o[0]); VRDH(0,1); ep=EX(SHX(C1[0])); sacc+=ep; PINF(ep); PIN(sacc); SBAR(); \
    o[1]=MF(BC8(PP0),VFR(4),o[1]); PIN(o[1]); VRDH(4,1); { const float e_=EX(SHX(C1[1])); sacc+=e_; PN2[0]=cvtpk_s(ep,e_); } PIN(PN2); PIN(sacc); SBAR(); \
    o[0]=MF(BC8(PP1),VFR(1),o[0]); PIN(o[0]); VRDH(1,1); ep=EX(SHX(C1[2])); sacc+=ep; PINF(ep); PIN(sacc); SBAR(); \
    o[1]=MF(BC8(PP1),VFR(5),o[1]); PIN(o[1]); VRDH(5,1); { const float e_=EX(SHX(C1[3])); sacc+=e_; PN2[1]=cvtpk_s(ep,e_); } PIN(PN2); PIN(sacc); SBAR(); \
    o[0]=MF(BC8(PP2),VFR(2),o[0]); PIN(o[0]); VRDH(2,1); ep=EX(SHX(C1[4])); sacc+=ep; PINF(ep); PIN(sacc); SBAR(); \
    o[1]=MF(BC8(PP2),VFR(6),o[1]); PIN(o[1]); VRDH(6,1); { const float e_=EX(SHX(C1[5])); sacc+=e_; PN2[2]=cvtpk_s(ep,e_); } PIN(PN2); PIN(sacc); SBAR(); \
    o[0]=MF(BC8(PP3),VFR(3),o[0]); PIN(o[0]); VRDH(3,1); ep=EX(SHX(C1[6])); sacc+=ep; PINF(ep); PIN(sacc); SBAR(); \
    o[1]=MF(BC8(PP3),VFR(7),o[1]); PIN(o[1]); VRDH(7,1); { const float e_=EX(SHX(C1[7])); sacc+=e_; PN2[3]=cvtpk_s(ep,e_); } PIN(PN2); PIN(sacc); SBAR(); \
    o[2]=MF(BC8(PP0),VFR(0),o[2]); PIN(o[2]); (void)0; ep=EX(SHX(C1[8])); sacc+=ep; PINF(ep); PIN(sacc); SBAR(); \
    o[3]=MF(BC8(PP0),VFR(4),o[3]); PIN(o[3]); (void)0; { const float e_=EX(SHX(C1[9])); sacc+=e_; PN3[0]=cvtpk_s(ep,e_); } PIN(PN3); PIN(sacc); SBAR(); \
    o[2]=MF(BC8(PP1),VFR(1),o[2]); PIN(o[2]); (void)0; ep=EX(SHX(C1[10])); sacc+=ep; PINF(ep); PIN(sacc); SBAR(); \
    o[3]=MF(BC8(PP1),VFR(5),o[3]); PIN(o[3]); (void)0; { const float e_=EX(SHX(C1[11])); sacc+=e_; PN3[1]=cvtpk_s(ep,e_); } PIN(PN3); PIN(sacc); SBAR(); \
    o[2]=MF(BC8(PP2),VFR(2),o[2]); PIN(o[2]); (void)0; ep=EX(SHX(C1[12])); sacc+=ep; PINF(ep); PIN(sacc); SBAR(); \
    o[3]=MF(BC8(PP2),VFR(6),o[3]); PIN(o[3]); KLDN(0); { const float e_=EX(SHX(C1[13])); sacc+=e_; PN3[2]=cvtpk_s(ep,e_); } PIN(PN3); PIN(sacc); SBAR(); \
    o[2]=MF(BC8(PP3),VFR(3),o[2]); PIN(o[2]); (void)0; ep=EX(SHX(C1[14])); sacc+=ep; PINF(ep); PIN(sacc); SBAR(); \
    o[3]=MF(BC8(PP3),VFR(7),o[3]); PIN(o[3]); KLDN(2); { const float e_=EX(SHX(C1[15])); sacc+=e_; PN3[3]=cvtpk_s(ep,e_); } PIN(PN3); PIN(sacc); SBAR(); \
    l_reg+=sacc; \
    }while(0)
  #define STEP_AB(t,GK,GV,GL) STEP(pa0,pa1,pa2,pa3,pb0,pb1,pb2,pb3,t,GK,GV,GL)
  #define STEP_BA(t,GK,GV,GL) STEP(pb0,pb1,pb2,pb3,pa0,pa1,pa2,pa3,t,GK,GV,GL)
  int t=1;
  #undef CMASK
  #define CMASK(P0,P1,t) do{}while(0)
  for(;t+5<NT;t+=2){
    STEP_AB(t,true,true,true);     WAIT_BAR(4); ROT();
    STEP_BA(t+1,true,true,true);   WAIT_BAR(4); ROT();
  }
  #undef CMASK
  #define CMASK(P0,P1,t) do{int jb_=(t)-(NT-2); if(jb_>=0)cmask(P0,P1,jb_,qrel,hi);}while(0)
  #define ENDW(tt) do{ if((tt)+3<NT){WAIT_BAR(4);} else if((tt)+2<NT){WAIT_BAR(2);} else {WAIT_BAR(0);} }while(0)
  for(;t+1<NT;t+=2){
    STEP_AB(t,(t+3<NT),(t+1<NT),(t+1<NT));       ENDW(t);   ROT();
    STEP_BA(t+1,(t+4<NT),(t+2<NT),(t+2<NT));     ENDW(t+1); ROT();
  }
  STEP_AB(NT-1,false,false,false);
  SBAR(); pv(o,vb0+2*sl_cur,BC8(pb0),BC8(pb1),BC8(pb2),BC8(pb3)); pv(o+2,vb0+2*sl_cur+8192,BC8(pb0),BC8(pb1),BC8(pb2),BC8(pb3));
  #undef PKW
  #undef BC8
  #undef VFR
  #undef PIN
  #undef MX3
  #undef GAPB
  #undef EX
  #undef MF
  #undef VRDH
  #undef KRD
  #undef KLD
  #undef PINF
  #undef KLDN
  #undef STEP
  #undef STEP_AB
  #undef STEP_BA
  #undef ENDW
  {auto rr=__builtin_amdgcn_permlane32_swap(__float_as_uint(l_reg),__float_as_uint(l_reg),false,false);l_reg=__uint_as_float(rr[0])+__uint_as_float(rr[1]);}
  if(hi==0)wsf[32+r32]=l_reg;asm volatile("s_waitcnt lgkmcnt(0)":::"memory");
  float rli[16];
  #pragma unroll
  for(int r=0;r<16;++r)rli[r]=__builtin_amdgcn_rcpf(wsf[32+crow(r,hi)]);
  asm volatile("s_waitcnt vmcnt(0) lgkmcnt(0)\n\ts_barrier":::"memory");
  { bf16*stg=(bf16*)(shm+LDS_OST)+wid*4096;
    #pragma unroll
    for(int r=0;r<16;++r){const int orow=crow(r,hi);
      #pragma unroll
      for(int d0=0;d0<4;++d0)stg[orow*128+d0*32+r32]=__float2bfloat16(o[d0][r]*rli[r]);} }
  asm volatile("s_waitcnt lgkmcnt(0)\n\ts_barrier":::"memory");
  { const bf16*st0=(const bf16*)(shm+LDS_OST);
    #pragma unroll
    for(int pss=0;pss<4;++pss){ const int row=wid*16+pss*4+(lane>>4),e=(lane&15)*8;
      const u32x4 a=*(const u32x4*)(st0+((row>>5)*4096+(row&31)*128+e)), bq=*(const u32x4*)(st0+((4+(row>>5))*4096+(row&31)*128+e));
      float d[8]; const unsigned aw[4]={a.x,a.y,a.z,a.w},bw[4]={bq.x,bq.y,bq.z,bq.w};
      #pragma unroll
      for(int i=0;i<4;++i){ d[2*i]=__uint_as_float(aw[i]<<16)-lam*__uint_as_float(bw[i]<<16); d[2*i+1]=__uint_as_float(aw[i]&0xffff0000u)-lam*__uint_as_float(bw[i]&0xffff0000u); }
      float ss=0.f;
      #pragma unroll
      for(int i=0;i<8;++i)ss+=d[i]*d[i];
      ss+=__shfl_xor(ss,1);ss+=__shfl_xor(ss,2);ss+=__shfl_xor(ss,4);ss+=__shfl_xor(ss,8);
      const float rstd=(1.f/sqrtf(ss*(1.f/128.f)+1e-5f))*0.8f;
      const float*sw=subw+e; u32x4 ov;
      ov.x=cvtpk_s(d[0]*rstd*sw[0],d[1]*rstd*sw[1]);ov.y=cvtpk_s(d[2]*rstd*sw[2],d[3]*rstd*sw[3]);ov.z=cvtpk_s(d[4]*rstd*sw[4],d[5]*rstd*sw[5]);ov.w=cvtpk_s(d[6]*rstd*sw[6],d[7]*rstd*sw[7]);
      ATTN_STORE16(MIXO+(rowbase+q0+row)*OPITCH+h*128+e,ov); } }
  asm volatile("s_waitcnt lgkmcnt(0)\n\ts_barrier":::"memory");
  #undef DMA_K
  #undef DMA_V
  #undef CMASK
  #undef SHX
  #undef ROT
}
constexpr int ATTN_LDS_BYTES=LDS_BYTES;
struct AttnTensors { const bf16* Q; const bf16* K; const bf16* V; bf16* MIX; float lam; float sh; const float* subw; const bf16* U; const bf16* GB; const float* convw; };
struct AttnUnit { int bh; int qb; int lin; };
struct StaticOrder {
  int vcu, G;
  __device__ __forceinline__ explicit StaticOrder(int grid,int block):vcu((grid%8==0)?(block%8)*(grid/8)+block/8:block),G(grid){}
  __device__ __forceinline__ bool next(int i,AttnUnit&u)const{
    if(G==256){ if(i>=2)return false; const int s=vcu&15; u.bh=vcu>>4; u.qb=(i&1)?31-s:s; u.lin=2*vcu+i; return true; }
    const int L=i*G+vcu; if(L>=16*NQB)return false; u.bh=L/NQB; u.qb=L%NQB; u.lin=L; return true; }
  __device__ __forceinline__ void a_ready(const AttnUnit&)const{}
  __device__ __forceinline__ void done(const AttnUnit&)const{}
};
template<class Sched,int THRL=8> __device__ __forceinline__ void attn_phase(char*lds,const AttnTensors&T,const Sched&S){
  AttnUnit u;
  if(__builtin_expect(T.sh==0.f,1)){ for(int i=0;S.next(i,u);++i){ S.a_ready(u); attn_unit<THRL,false>(u.bh>>3,u.bh&7,u.qb,u.lin,0.f,T.Q,T.K,T.V,T.MIX,T.lam,T.subw,T.U,T.GB,T.convw,lds); S.done(u); } }
  else { for(int i=0;S.next(i,u);++i){ S.a_ready(u); attn_unit<THRL,true>(u.bh>>3,u.bh&7,u.qb,u.lin,T.sh,T.Q,T.K,T.V,T.MIX,T.lam,T.subw,T.U,T.GB,T.convw,lds); S.done(u); } }
}
#undef SBAR
#undef WAIT_BAR
}
#include <hip/hip_cooperative_groups.h>
namespace cg = cooperative_groups;

constexpr int NWAVES = 8;
#ifndef MK_N_LAUNCHES
#define MK_N_LAUNCHES 1
#endif
constexpr int N_LAUNCHES = MK_N_LAUNCHES, N_PHASES = 9;

constexpr int BATCH = 2, SEQ = 4096, DMODEL = 2048, M = BATCH * SEQ;
constexpr int NH = 8, AW = 1024, CWID = 1024, INC = 6144, DFF = 5632;
constexpr float RMS_EPS = 1e-6f, SUBLN_EPS = 1e-5f, LAM_INIT = 0.2f;
constexpr size_t MiB = 1u << 20;
constexpr size_t WS_SS = 0;
constexpr size_t WS_ROPE = 1 * MiB;
constexpr size_t WS_WIN = 2 * MiB, WS_WOUT = 26 * MiB, WS_WGU = 34 * MiB, WS_WDN = 78 * MiB;
constexpr size_t WS_XN = 100 * MiB;
constexpr size_t WS_Q = 132 * MiB, WS_K = 148 * MiB, WS_V = 164 * MiB, WS_GB = 180 * MiB, WS_GC = 196 * MiB, WS_HC = 212 * MiB;
constexpr size_t WS_MIX = 212 * MiB;
constexpr size_t WS_H1 = 132 * MiB;
constexpr size_t WS_H = 164 * MiB;
constexpr size_t WS_BAR = 252 * MiB, BAR_BYTES = 16384;
constexpr size_t WS_RS = 252 * MiB + BAR_BYTES;
constexpr size_t WS_END = WS_RS + (size_t)M * 4;
static_assert(WS_WIN + (size_t)INC * DMODEL * 2 <= WS_WOUT && WS_WOUT + (size_t)DMODEL * DMODEL * 2 <= WS_WGU && WS_WGU + (size_t)2 * DFF * DMODEL * 2 <= WS_WDN && WS_WDN + (size_t)DMODEL * DFF * 2 <= WS_XN, "weights map");
static_assert(WS_XN + (size_t)M * DMODEL * 2 <= WS_Q && WS_HC + (size_t)M * 1024 * 2 <= WS_BAR && WS_H + (size_t)M * DFF * 2 <= WS_BAR && WS_H1 + (size_t)M * DMODEL * 2 <= WS_H, "activation map");
constexpr int RING_BYTES = 131072, LDS_BYTES = 147456;
static_assert(attn_body::ATTN_LDS_BYTES <= RING_BYTES && pg8::STAGE_BYTES <= RING_BYTES, "LDS map");

#define GAS __attribute__((address_space(1)))
#define LAS __attribute__((address_space(3)))
typedef unsigned short bf16;
typedef unsigned v4u __attribute__((ext_vector_type(4)));
typedef float f32x4 __attribute__((ext_vector_type(4)));
typedef float f32x2 __attribute__((ext_vector_type(2)));
#define LDS_WAIT() asm volatile("s_waitcnt lgkmcnt(0)" ::: "memory")
__device__ __forceinline__ unsigned f2bf(float f) { unsigned u = __builtin_bit_cast(unsigned, f); return (u + 0x7fffu + ((u >> 16) & 1u)) >> 16; }
__device__ __forceinline__ unsigned pk2(float lo, float hi) { return f2bf(lo) | (f2bf(hi) << 16); }
__device__ __forceinline__ float bf_lo(unsigned w) { return __builtin_bit_cast(float, w << 16); }
__device__ __forceinline__ float bf_hi(unsigned w) { return __builtin_bit_cast(float, w & 0xffff0000u); }
__device__ __forceinline__ float wave_sum(float v) {
#pragma unroll
    for (int o = 1; o < 64; o <<= 1) v += __shfl_xor(v, o);
    return v;
}
__device__ __forceinline__ void p0_transpose_tile(const float* W, int N, int k0, int n0, bf16* WT, int K, int drow0, LAS float* scr, int lane, const float* kscale = nullptr) {
    float tv[32];
#pragma unroll
    for (int i = 0; i < 32; ++i) tv[i] = __builtin_nontemporal_load(W + (size_t)(k0 + 2 * i + (lane >> 5)) * N + n0 + (lane & 31));
#pragma unroll
    for (int i = 0; i < 32; ++i) scr[(2 * i + (lane >> 5)) * 33 + (lane & 31)] = kscale ? tv[i] * kscale[k0 + 2 * i + (lane >> 5)] : tv[i];
    LDS_WAIT(); asm volatile("" ::: "memory");
    const int c = lane & 7;
#pragma unroll
    for (int j = 0; j < 4; ++j) { const int n = (lane >> 3) + 8 * j; const LAS float* s = scr + (8 * c) * 33 + n;
        v4u o; o.x = pk2(s[0 * 33], s[1 * 33]); o.y = pk2(s[2 * 33], s[3 * 33]); o.z = pk2(s[4 * 33], s[5 * 33]); o.w = pk2(s[6 * 33], s[7 * 33]);
        *(GAS v4u*)(WT + (size_t)(drow0 + n) * K + k0 + 8 * c) = o; }
    LDS_WAIT(); asm volatile("" ::: "memory");
}
__device__ __forceinline__ void x_row_to_bf16(const float* xrow, bf16* orow, float* rs, int lane) {
    const GAS f32x4* xr = (const GAS f32x4*)xrow + lane; f32x4 v[8]; float s = 0.f;
#pragma unroll
    for (int j = 0; j < 8; ++j) { v[j] = __builtin_nontemporal_load(xr + 64 * j); s += (v[j].x * v[j].x + v[j].y * v[j].y) + (v[j].z * v[j].z + v[j].w * v[j].w); }
    const float rstd = 1.f / sqrtf(wave_sum(s) * (1.f / DMODEL) + RMS_EPS); if (lane == 0) *rs = rstd;
    GAS unsigned long long* o8 = (GAS unsigned long long*)orow + lane;
#pragma unroll
    for (int j = 0; j < 8; ++j) o8[64 * j] = (unsigned long long)pk2(v[j].x, v[j].y) | ((unsigned long long)pk2(v[j].z, v[j].w) << 32);
}
__device__ __forceinline__ void rms_row_to_bf16(const float* xrow, const float* w, bf16* orow, int lane) {
    const GAS f32x4* xr = (const GAS f32x4*)xrow + lane; const GAS f32x4* wr = (const GAS f32x4*)w + lane;
    f32x4 v[8]; float s = 0.f;
#pragma unroll
    for (int j = 0; j < 8; ++j) { v[j] = __builtin_nontemporal_load(xr + 64 * j); s +=     (v[j].x * v[j].x + v[j].y * v[j].y) + (v[j].z * v[j].z + v[j].w * v[j].w); }
    const float rstd = 1.f / sqrtf(wave_sum(s) * (1.f / DMODEL) + RMS_EPS);
    GAS unsigned long long* o8 = (GAS unsigned long long*)orow + lane;
#pragma unroll
    for (int j = 0; j < 8; ++j) { const f32x4 ww = wr[64 * j];
        o8[64 * j] = (unsigned long long)pk2(v[j].x * rstd * ww.x, v[j].y * rstd * ww.y) | ((unsigned long long)pk2(v[j].z * rstd * ww.z, v[j].w * rstd * ww.w) << 32); }
}

#define XB_TMO      128
#define XB_XCNT(j)  (256  + 64 * (j))
#define XB_XSUB(j)  (1280 + 64 * (j))
#define XB_XGEN(j)  (2304 + 64 * (j))
#define XB_TOP      3328
#define XB_TOPGEN   3392
#define XCD_BAR_WORDS 3456
#define XB_SPIN_CAP (1u << 18)

__device__ __forceinline__ unsigned xb_ld(unsigned* p)              { return __hip_atomic_load(p, __ATOMIC_RELAXED, __HIP_MEMORY_SCOPE_AGENT); }
__device__ __forceinline__ unsigned xb_add(unsigned* p, unsigned v) { return __hip_atomic_fetch_add(p, v, __ATOMIC_RELAXED, __HIP_MEMORY_SCOPE_AGENT); }
__device__ __forceinline__ unsigned xb_xcc_id() { return (unsigned)__builtin_amdgcn_s_getreg((3 << 11) | 20) & 0xFu; }
#define XB_SPIN(cond, bar) do { unsigned _sp = 0; while (cond) { __builtin_amdgcn_s_sleep(1); \
    if ((++_sp & 255u) == 0u) { if (xb_ld(&(bar)[XB_TMO])) break; if (_sp > XB_SPIN_CAP) { atomicAdd(&(bar)[XB_TMO], 1u); break; } } } } while (0)

struct XcdBarrier {
    unsigned* bar; unsigned x;
    volatile LAS unsigned* st;
};

__device__ __forceinline__ XcdBarrier xcd_barrier_post(unsigned* bar, volatile LAS unsigned* st) {
    XcdBarrier b; b.bar = bar; b.x = xb_xcc_id(); b.st = st;
    if (threadIdx.x == 0) (void)xb_add(&bar[XB_XCNT(b.x)], 1u);
    return b;
}
__device__ __forceinline__ void xcd_barrier_complete(unsigned* bar, unsigned x, unsigned& nloc, unsigned& nx) {
    const unsigned G = gridDim.x * gridDim.y * gridDim.z;
    unsigned sum, cnt, mine, sp = 0u;
    for (;;) {
        sum = 0u; cnt = 0u; mine = 0u;
#pragma unroll
        for (unsigned j = 0; j < 16; ++j) { const unsigned c = xb_ld(&bar[XB_XCNT(j)]); sum += c; cnt += (c > 0u) ? 1u : 0u; mine = (j == x) ? c : mine; }
        if (sum == G) break;
        __builtin_amdgcn_s_sleep(1);
        if ((++sp & 255u) == 0u) { if (xb_ld(&bar[XB_TMO])) break; if (sp > XB_SPIN_CAP) { atomicAdd(&bar[XB_TMO], 1u); break; } }
    }
    nloc = mine > 0u ? mine : 1u; nx = cnt > 0u ? cnt : 1u;
}

__device__ __forceinline__ void xcd_barrier(const XcdBarrier& b) {
    asm volatile("s_waitcnt vmcnt(0)" ::: "memory");
    __syncthreads();
    if (threadIdx.x == 0) {
        unsigned* bar = b.bar;
        __builtin_amdgcn_s_waitcnt(0);
        unsigned nloc = b.st[0], nx = b.st[1];
        if (nloc == 0u) { xcd_barrier_complete(bar, b.x, nloc, nx); b.st[0] = nloc; b.st[1] = nx; }
        const unsigned old = xb_add(&bar[XB_XSUB(b.x)], 1u);
        const unsigned gen = old / nloc;
        if (old + 1u == (gen + 1u) * nloc) {
            __builtin_amdgcn_fence(__ATOMIC_RELEASE, "agent");
            asm volatile("s_waitcnt vmcnt(0)" ::: "memory");
            const unsigned og = xb_add(&bar[XB_TOP], 1u);
            const unsigned tg = og / nx;
            if (og + 1u == (tg + 1u) * nx) xb_add(&bar[XB_TOPGEN], 1u);
            else XB_SPIN(xb_ld(&bar[XB_TOPGEN]) == tg, bar);
            __builtin_amdgcn_fence(__ATOMIC_ACQUIRE, "agent");
            xb_add(&bar[XB_XGEN(b.x)], 1u);
            asm volatile("s_waitcnt vmcnt(0)" ::: "memory");
        } else {
            XB_SPIN(xb_ld(&bar[XB_XGEN(b.x)]) == gen, bar);
            __builtin_amdgcn_fence(__ATOMIC_ACQUIRE, "agent");
            asm volatile("s_waitcnt vmcnt(0)" ::: "memory");
        }
    }
    __syncthreads();
}

struct Args { const float* in[16]; float* out; unsigned char* ws; int ph_lo, ph_hi; };

__global__ void __launch_bounds__(NWAVES * 64, 2) block_fwd(Args args) {
    extern __shared__ __attribute__((aligned(16))) unsigned char lds[];
    cg::grid_group grid = cg::this_grid();
    const int tid = threadIdx.x, lane = tid & 63, wave = __builtin_amdgcn_readfirstlane(tid >> 6);
    const int G = gridDim.x; const int bx = blockIdx.x; const int vcu = (G % 8 == 0) ? (bx % 8) * (G / 8) + bx / 8 : bx;
    const int gw = vcu * NWAVES + wave, NGW = G * NWAVES;
    LAS unsigned char* ldsl = (LAS unsigned char*)lds;
    unsigned char* ws = args.ws;
    const float* x = args.in[0]; const float* attn_norm_w = args.in[1]; const float* w_in = args.in[2]; const float* q_norm_w = args.in[3]; const float* k_norm_w = args.in[4];
    const float* lq1 = args.in[5]; const float* lk1 = args.in[6]; const float* lq2 = args.in[7]; const float* lk2 = args.in[8]; const float* subln_w = args.in[9];
    const float* conv_w = args.in[10]; const float* w_out = args.in[11]; const float* ffn_norm_w = args.in[12]; const float* w_gate = args.in[13]; const float* w_up = args.in[14]; const float* w_down = args.in[15];
    float* out = args.out;
    bf16* Win_t = (bf16*)(ws + WS_WIN); bf16* Wout_t = (bf16*)(ws + WS_WOUT); bf16* Wgu_t = (bf16*)(ws + WS_WGU); bf16* Wdn_t = (bf16*)(ws + WS_WDN);
    bf16* XN = (bf16*)(ws + WS_XN); bf16* QB_ = (bf16*)(ws + WS_Q); bf16* KB_ = (bf16*)(ws + WS_K); bf16* VB_ = (bf16*)(ws + WS_V);
    bf16* GB_ = (bf16*)(ws + WS_GB); bf16* GC_ = (bf16*)(ws + WS_GC); bf16* HC_ = (bf16*)(ws + WS_HC); bf16* MIX = (bf16*)(ws + WS_MIX); bf16* HB = (bf16*)(ws + WS_H); bf16* H1 = (bf16*)(ws + WS_H1);
    f32x2* ROPE = (f32x2*)(ws + WS_ROPE); float* SS = (float*)(ws + WS_SS); float* RS = (float*)(ws + WS_RS);

    const int lo = args.ph_lo, hi = args.ph_hi;
#define IN(k) (lo <= (k) && (k) < hi)
    volatile LAS unsigned* MISC = (volatile LAS unsigned*)(ldsl + LDS_BYTES - 64);
    XcdBarrier bar; bar.bar = (unsigned*)(ws + WS_BAR); bar.x = 0; bar.st = nullptr;
    if (hi - lo > 1) { if (tid < 2) MISC[tid] = 0u; __syncthreads(); bar = xcd_barrier_post((unsigned*)(ws + WS_BAR), MISC); }
#define SEAM(k) do { if (IN(k) && hi > (k) + 1) xcd_barrier(bar); } while (0)
    if (hi < lo) grid.sync();

    if (IN(0)) {
        LAS float* scr = (LAS float*)(ldsl + wave * 16384);
        constexpr int I_IN = (DMODEL / 64) * (INC / 32), I_OUT = (DMODEL / 64) * (DMODEL / 32), I_G = (DMODEL / 64) * (DFF / 32), I_DN = (DFF / 64) * (DMODEL / 32);
        constexpr int NITEMS = I_IN + I_OUT + 2 * I_G;
        for (int it = gw; it < NITEMS; it += NGW) {
            int r = it;
            if (r < I_IN) { const int nb = INC / 32, kb = r / nb, n0 = 32 * (r % nb); const int seg = n0 >> 10, c = n0 & 1023;
                const int qk = 128 * ((c >> 5) & 1) + 32 * ((c >> 6) & 3);
                const int drow = seg == 0 ? 256 * (c >> 8) + qk : seg == 1 ? 256 * (12 + (c >> 8)) + qk : seg == 2 ? 256 * 4 + c : seg == 3 ? 256 * 16 + c
                               : 256 * (((c >> 7) < 4 ? 8 : 16) + (c >> 7)) + (c & 127) + (seg == 5 ? 128 : 0);
                p0_transpose_tile(w_in, INC, 64 * kb, n0, Win_t, DMODEL, drow, scr, lane, attn_norm_w); continue; }     r -= I_IN;
            if (r < I_OUT) { const int nb = DMODEL / 32, kb = r / nb, n0 = 32 * (r % nb); p0_transpose_tile(w_out, DMODEL, 64 * kb, n0, Wout_t, DMODEL, n0, scr, lane); continue; } r -= I_OUT;
            if (r < 2 * I_G) { const bool up = r >= I_G; if (up) r -= I_G; const int nb = DFF / 32, kb = r / nb, n0 = 32 * (r % nb);
                p0_transpose_tile(up ? w_up : w_gate, DFF, 64 * kb, n0, Wgu_t, DMODEL, (n0 >> 7) * 256 + (n0 & 127) + (up ? 128 : 0), scr, lane, ffn_norm_w); continue; }
        }
        for (int e = vcu * (NWAVES * 64) + tid; e < SEQ * 32; e += G * NWAVES * 64) {
            const int pos = e >> 5, i = e & 31; double inv = 1.0; for (int k = 0; k < i; ++k) inv *= 0.7498942093324558;
            const float ang = (float)pos * (float)inv; double rev = (double)ang * 0.15915494309189535; rev -= __builtin_floor(rev);
            const float fr = (float)rev; ROPE[e] = (f32x2){__builtin_amdgcn_cosf(fr), __builtin_amdgcn_sinf(fr)}; }
        for (int m = gw; m < M; m += NGW) x_row_to_bf16(x + (size_t)m * DMODEL, XN + (size_t)m * DMODEL, RS + m, lane);
    }
    SEAM(0);
    if (IN(1)) {
        pg8::Gemm g{XN, Win_t, M, INC, DMODEL}; pg8::StaticOrder S; S.init(M, INC, G, bx);
        LAS float* rxt = (LAS float*)(ldsl + RING_BYTES);
        { pg8::Unit uu; for (int i = (tid >> 8); i < 4; i += 2) if (S.next(i, uu)) rxt[256 * i + (tid & 255)] = RS[uu.pm * 256 + (tid & 255)];
          if (S.next(4, uu)) __builtin_trap();
          __syncthreads(); }
        pg8::EpiInProj E{QB_, (size_t)(WS_K - WS_Q) / 2, q_norm_w, k_norm_w, (const float*)ROPE, attn_body::C2, SEQ - 1, rxt};
        pg8::gemm_phase<pg8::EpiInProj, pg8::StaticOrder, PG8_ALIGN, PG8_SP2>(ldsl, g, S, E);
    }
    SEAM(1);
    if (IN(3)) {
        const float s1 = wave_sum(lq1[lane] * lk1[lane]), s2 = wave_sum(lq2[lane] * lk2[lane]);
        const float lam = __builtin_amdgcn_exp2f(s1 * 1.4426950408889634f) - __builtin_amdgcn_exp2f(s2 * 1.4426950408889634f) + LAM_INIT;
        float mq = __builtin_fabsf(q_norm_w[lane]), mk = __builtin_fabsf(k_norm_w[lane]);
#pragma unroll
        for (int o_ = 1; o_ < 64; o_ <<= 1) { mq = __builtin_fmaxf(mq, __shfl_xor(mq, o_)); mk = __builtin_fmaxf(mk, __shfl_xor(mk, o_)); }
        const float sbound = 64.0f * 1.02f * attn_body::C2 * mq * mk, shv = sbound > 64.0f ? sbound - 64.0f : 0.0f;
        __syncthreads();
        const attn_body::AttnTensors AT{(const attn_body::bf16*)QB_, (const attn_body::bf16*)KB_, (const attn_body::bf16*)VB_, (attn_body::bf16*)MIX, lam, shv, subln_w, (const attn_body::bf16*)GC_, (const attn_body::bf16*)GB_, conv_w};
        const attn_body::StaticOrder S(G, bx);
        attn_body::attn_phase<attn_body::StaticOrder>((char*)lds, AT, S);
    }
    SEAM(3);
    if (IN(5)) {
        pg8::Gemm g{MIX, Wout_t, M, DMODEL, DMODEL}; pg8::StaticOrder S; S.init(M, DMODEL, G, bx);
        pg8::EpiResStats E{XN, DMODEL, H1, SS};
        pg8::gemm_phase<pg8::EpiResStats, pg8::StaticOrder, PG8_ALIGN, PG8_SP2>(ldsl, g, S, E);
    }
    SEAM(5);
    if (IN(7)) {
        pg8::Gemm g{H1, Wgu_t, M, 2 * DFF, DMODEL}; pg8::StaticOrder S; S.init(M, 2 * DFF, G, bx);
        LAS float* rtab = (LAS float*)(ldsl + RING_BYTES);
        {
            pg8::Unit uu; f32x4 sv[3][8]; bool have[3];
#pragma unroll
            for (int j = 0; j < 3; ++j) { have[j] = S.next(2 * j + (tid >> 8), uu);
                if (have[j]) { const f32x4* sp = (const f32x4*)(SS + (size_t)(uu.pm * 256 + (tid & 255)) * 32);
#pragma unroll
                    for (int q = 0; q < 8; ++q) sv[j][q] = sp[q]; } }
#pragma unroll
            for (int j = 0; j < 3; ++j) if (have[j]) { f32x4 a = sv[j][0];
#pragma unroll
                for (int q = 1; q < 8; ++q) a += sv[j][q];
                rtab[256 * (2 * j + (tid >> 8)) + (tid & 255)] = 1.0f / sqrtf(((a[0] + a[1]) + (a[2] + a[3])) * (1.0f / DMODEL) + RMS_EPS); }
            pg8::Unit u6; if (S.next(6, u6)) __builtin_trap();
            __syncthreads();
        }
        pg8::EpiSwiGLU E{HB, DFF, rtab};
        pg8::gemm_phase<pg8::EpiSwiGLU, pg8::StaticOrder, PG8_ALIGN, PG8_SP2>(ldsl, g, S, E);
        {
            constexpr int I_DN = (DFF / 64) * (DMODEL / 32); const int nwg7 = (M / 256) * (2 * DFF / 256), rounds = (nwg7 + G - 1) / G, nidle = rounds * G - nwg7;
            const int hidx = nidle ? bx - (G - nidle) : bx, nh = nidle ? nidle : G; LAS float* scr = (LAS float*)(ldsl + wave * 16384);
            if (hidx >= 0) for (int r = hidx * NWAVES + wave; r < I_DN; r += nh * NWAVES) { const int nb = DMODEL / 32, kb = r / nb, n0 = 32 * (r % nb); p0_transpose_tile(w_down, DMODEL, 64 * kb, n0, Wdn_t, DFF, n0, scr, lane); }
        }
    }
    SEAM(7);
    if (IN(8)) {
        pg8::Gemm g{HB, Wdn_t, M, DMODEL, DFF}; pg8::StaticOrder S; S.init(M, DMODEL, G, bx);
        pg8::EpiResOut E{H1, out, DMODEL};
        pg8::gemm_phase<pg8::EpiResOut, pg8::StaticOrder, PG8_ALIGN, PG8_SP2>(ldsl, g, S, E);
    }
#undef IN
#undef SEAM
}

extern "C" void kernel_launch(void* const* d_in, const int* in_sizes, int n_in, void* d_out, int out_size, void* d_ws, size_t ws_size, hipStream_t stream) {
    static int grid = 0;
    if (grid == 0) {
        if (n_in != 16 || in_sizes[0] != M * DMODEL || out_size != M * DMODEL || ws_size < WS_END) { fprintf(stderr, "kernel_launch: unexpected shapes (n_in %d, in0 %d, out %d, ws %zu); nothing launched\n", n_in, n_in > 0 ? in_sizes[0] : -1, out_size, ws_size); grid = -1; return; }
        int dev = 0, cus = 0, per_cu = 0;
        if (hipGetDevice(&dev) != hipSuccess || hipDeviceGetAttribute(&cus, hipDeviceAttributeMultiprocessorCount, dev) != hipSuccess) { fprintf(stderr, "kernel_launch: device query failed\n"); grid = -1; return; }
        if (hipFuncSetAttribute((const void*)block_fwd, hipFuncAttributeMaxDynamicSharedMemorySize, LDS_BYTES) != hipSuccess) { fprintf(stderr, "kernel_launch: hipFuncSetAttribute failed\n"); grid = -1; return; }
        if (hipOccupancyMaxActiveBlocksPerMultiprocessor(&per_cu, (const void*)block_fwd, NWAVES * 64, LDS_BYTES) != hipSuccess || per_cu < 1) { fprintf(stderr, "kernel_launch: occupancy query says %d\n", per_cu); per_cu = 1; }
        (void)hipGetLastError();
        grid = cus * per_cu;
    }
    if (grid < 0) return;
    if (N_LAUNCHES == 1 && hipMemsetAsync((char*)d_ws + WS_BAR, 0, BAR_BYTES, stream) != hipSuccess) { fprintf(stderr, "kernel_launch: hipMemsetAsync of the barrier words failed\n"); return; }
    Args a{};
    for (int i = 0; i < 16; ++i) a.in[i] = (const float*)d_in[i];
    a.out = (float*)d_out; a.ws = (unsigned char*)d_ws;
    if (N_LAUNCHES == 1) {
        a.ph_lo = 0; a.ph_hi = N_PHASES; void* kargs[] = {&a};
        const hipError_t e = hipLaunchCooperativeKernel((const void*)block_fwd, dim3(grid), dim3(NWAVES * 64), kargs, LDS_BYTES, stream);
        if (e != hipSuccess) fprintf(stderr, "kernel_launch: cooperative launch failed: %s (grid %d)\n", hipGetErrorString(e), grid);
    } else {
        for (int p = 0; p < N_PHASES; ++p) { a.ph_lo = p; a.ph_hi = p + 1; hipLaunchKernelGGL(block_fwd, dim3(grid), dim3(NWAVES * 64), LDS_BYTES, stream, a); }
    }
}
```
